# Optimizing an MI355X kernel written in HIP

```python
import math
import jax, jax.numpy as jnp
from jax import lax
import numpy as np

D_MODEL = 1024
BATCH = 8
SEQ = 2048
DEPTH = 1

D_MIX = D_MODEL
GLA_WIDTH = D_MIX // 2
GLA_HEADS = 4
GLA_DV = GLA_WIDTH // GLA_HEADS
GLA_DK = GLA_DV // 2
GLA_KW = GLA_HEADS * GLA_DK
GLA_GATE_RANK = 16
GLA_GATE_NORM = 16.0
SSD_WIDTH = D_MIX - GLA_WIDTH
SSD_HEADDIM = 64
SSD_HEADS = SSD_WIDTH // SSD_HEADDIM
SSD_GROUPS = 2
SSD_HPG = SSD_HEADS // SSD_GROUPS
SSD_STATE = 128
SSD_CONV = 4
SSD_CONV_CH = SSD_WIDTH + 2 * SSD_GROUPS * SSD_STATE
CHUNK = 64
IN_SPLITS = [GLA_KW, GLA_KW, GLA_WIDTH, GLA_WIDTH, GLA_GATE_RANK,
             SSD_WIDTH, SSD_CONV_CH, SSD_HEADS]
D_IN = sum(IN_SPLITS)
N_EXPERTS = 32
TOP_K = 4
D_FF = D_MODEL
SWIGLU_LIMIT = 7.0
SWIGLU_ALPHA = 1.702
EPS = 1e-6
GROUP_EPS = 1e-5

kernel_name = "hymba_gla_ssd_moe_block"


def rmsnorm(x, w, eps=EPS):
    xf = x.astype(jnp.float32)
    y = xf * lax.rsqrt(jnp.mean(xf * xf, axis=-1, keepdims=True) + eps)
    return (y * w.astype(jnp.float32)).astype(x.dtype)


def gla_chunked(q, k, v, log_a):
    bsz, seqlen, heads, _ = q.shape
    dv = v.shape[-1]
    n = seqlen // CHUNK

    def to_chunks(t):
        return jnp.moveaxis(t.reshape(bsz, n, CHUNK, heads, t.shape[-1]), 1, 0).transpose(0, 1, 3, 2, 4)

    bcum = jnp.cumsum(to_chunks(log_a), axis=3)
    mask = jnp.tril(jnp.ones((CHUNK, CHUNK), bool))[:, :, None]

    def step(state, inp):
        qc, kc, vc, bc = inp
        inter = jnp.einsum('bhcd,bhdv->bhcv', qc * jnp.exp(bc), state)
        diff = bc[:, :, :, None, :] - bc[:, :, None, :, :]
        decay = jnp.where(mask, jnp.exp(jnp.where(mask, diff, 0.0)), 0.0)
        scores = jnp.einsum('bhid,bhjd,bhijd->bhij', qc, kc, decay)
        intra = jnp.einsum('bhij,bhjv->bhiv', scores, vc)
        b_last = bc[:, :, -1, :]
        state = state * jnp.exp(b_last)[..., None] + jnp.einsum(
            'bhcd,bhcv->bhdv', kc * jnp.exp(b_last[:, :, None, :] - bc), vc)
        return state, inter + intra

    s0 = jnp.zeros((bsz, heads, q.shape[-1], dv), jnp.float32)
    _, o = lax.scan(step, s0, (to_chunks(q), to_chunks(k), to_chunks(v), bcum))
    return o.transpose(1, 0, 3, 2, 4).reshape(bsz, seqlen, heads, dv)


def ssd_chunked(x, dt, a_neg, bm, cm):
    bsz, seqlen = x.shape[:2]
    n = seqlen // CHUNK

    def to_chunks(t):
        return jnp.moveaxis(t.reshape(bsz, n, CHUNK, *t.shape[2:]), 1, 0)

    acum = jnp.cumsum(to_chunks(dt * a_neg), axis=2)
    mask = jnp.tril(jnp.ones((CHUNK, CHUNK), bool))[None, :, :, None, None]

    def step(state, inp):
        xc, dtc, ac, bc, cc = inp
        seg = ac[:, :, None] - ac[:, None, :]
        lmat = jnp.where(mask, jnp.exp(jnp.where(mask, seg, 0.0)), 0.0)
        cb = jnp.einsum('bign,bjgn->bijg', cc, bc)
        intra = jnp.einsum('bijg,bijgh,bjghp->bighp', cb, lmat, xc * dtc[..., None])
        inter = jnp.einsum('bign,bghpn->bighp', cc, state) * jnp.exp(ac)[..., None]
        a_last = ac[:, -1]
        wgt = jnp.exp(a_last[:, None] - ac) * dtc
        state = state * jnp.exp(a_last)[..., None, None] + jnp.einsum(
            'bjgn,bjgh,bjghp->bghpn', bc, wgt, xc)
        return state, intra + inter

    s0 = jnp.zeros((bsz, SSD_GROUPS, SSD_HPG, SSD_HEADDIM, SSD_STATE), jnp.float32)
    _, y = lax.scan(step, s0, (to_chunks(x), to_chunks(dt), acum, to_chunks(bm), to_chunks(cm)))
    return jnp.moveaxis(y, 0, 1).reshape(x.shape)


def moe_ffn(h, router_w, router_b, w_gate, b_gate, w_up, b_up, w_down, b_down):
    bsz, seqlen, d = h.shape
    hf = h.reshape(-1, d)
    t = hf.shape[0]
    logits = hf.astype(jnp.float32) @ router_w.astype(jnp.float32) + router_b.astype(jnp.float32)
    top_vals, top_idx = lax.top_k(logits, TOP_K)
    gates = jax.nn.softmax(top_vals, axis=-1)
    flat_e = top_idx.reshape(-1)
    order = jnp.argsort(flat_e)
    tok = order // TOP_K
    sorted_e = flat_e[order]
    group_sizes = jnp.bincount(flat_e, length=N_EXPERTS).astype(jnp.int32)
    xs = hf[tok]
    gate = lax.ragged_dot(xs, w_gate, group_sizes) + b_gate[sorted_e]
    up = lax.ragged_dot(xs, w_up, group_sizes) + b_up[sorted_e]
    gate = jnp.minimum(gate, SWIGLU_LIMIT)
    up = jnp.clip(up, -SWIGLU_LIMIT, SWIGLU_LIMIT)
    act = (up + 1.0) * (gate * jax.nn.sigmoid(SWIGLU_ALPHA * gate))
    out = lax.ragged_dot(act, w_down, group_sizes) + b_down[sorted_e]
    wsel = gates.reshape(-1)[order].astype(out.dtype)
    y = jnp.zeros((t, d), out.dtype).at[tok].add(out * wsel[:, None])
    return y.reshape(bsz, seqlen, d).astype(h.dtype)


def setup_inputs(seed: int = 0) -> dict:
    key = jax.random.key(seed)
    ks = jax.random.split(key, 24)
    f32 = jnp.float32

    def nrm(k, shape, fan_in):
        return jax.random.normal(k, shape, f32) * (fan_in ** -0.5)

    def gain(k, shape):
        return 1.0 + 0.02 * jax.random.normal(k, shape, f32)

    dt = jnp.exp(jax.random.uniform(ks[9], (DEPTH, SSD_HEADS), f32, math.log(1e-3), math.log(1e-1)))
    return {
        "x": jax.random.normal(ks[0], (BATCH, SEQ, D_MODEL), f32),
        "norm_mix_w": gain(ks[1], (DEPTH, D_MODEL)),
        "w_in": nrm(ks[2], (DEPTH, D_MODEL, D_IN), D_MODEL),
        "gla_w_alpha_up": nrm(ks[3], (DEPTH, GLA_GATE_RANK, GLA_KW), GLA_GATE_RANK),
        "gla_b_alpha": 0.1 * jax.random.normal(ks[4], (DEPTH, GLA_KW), f32) + 2.0,
        "gla_norm_w": gain(ks[5], (DEPTH, GLA_WIDTH)),
        "ssd_conv_w": nrm(ks[6], (DEPTH, SSD_CONV, SSD_CONV_CH), SSD_CONV),
        "ssd_conv_b": 0.02 * jax.random.normal(ks[7], (DEPTH, SSD_CONV_CH), f32),
        "ssd_dt_bias": dt + jnp.log(-jnp.expm1(-dt)),
        "ssd_A_log": jnp.log(jax.random.uniform(ks[10], (DEPTH, SSD_HEADS), f32, 1.0, 16.0)),
        "ssd_D": gain(ks[11], (DEPTH, SSD_HEADS)),
        "ssd_norm_w": gain(ks[12], (DEPTH, SSD_WIDTH)),
        "w_out": nrm(ks[13], (DEPTH, D_MIX, D_MODEL), D_MIX),
        "norm_ffn_w": gain(ks[14], (DEPTH, D_MODEL)),
        "router_w": nrm(ks[15], (DEPTH, D_MODEL, N_EXPERTS), D_MODEL),
        "router_b": 0.01 * jax.random.normal(ks[16], (DEPTH, N_EXPERTS), f32),
        "moe_w_gate": nrm(ks[17], (DEPTH, N_EXPERTS, D_MODEL, D_FF), D_MODEL),
        "moe_b_gate": 0.02 * jax.random.normal(ks[18], (DEPTH, N_EXPERTS, D_FF), f32),
        "moe_w_up": nrm(ks[19], (DEPTH, N_EXPERTS, D_MODEL, D_FF), D_MODEL),
        "moe_b_up": 0.02 * jax.random.normal(ks[20], (DEPTH, N_EXPERTS, D_FF), f32),
        "moe_w_down": nrm(ks[21], (DEPTH, N_EXPERTS, D_FF, D_MODEL), D_FF),
        "moe_b_down": 0.02 * jax.random.normal(ks[22], (DEPTH, N_EXPERTS, D_MODEL), f32),
        "final_norm_w": gain(ks[23], (D_MODEL,)),
    }


def reference(x, norm_mix_w, w_in, gla_w_alpha_up, gla_b_alpha, gla_norm_w, ssd_conv_w, ssd_conv_b,
              ssd_dt_bias, ssd_A_log, ssd_D, ssd_norm_w, w_out, norm_ffn_w, router_w, router_b,
              moe_w_gate, moe_b_gate, moe_w_up, moe_b_up, moe_w_down, moe_b_down, final_norm_w):
    bsz, seqlen, _ = x.shape
    f32 = jnp.float32
    split_pts = list(np.cumsum(IN_SPLITS)[:-1])
    for l in range(DEPTH):
        h = rmsnorm(x, norm_mix_w[l])
        proj = h @ w_in[l]
        q, k, v, g, a_low, z, xbc, dt_raw = jnp.split(proj, split_pts, axis=-1)

        qh = q.astype(f32).reshape(bsz, seqlen, GLA_HEADS, GLA_DK) * (GLA_DK ** -0.5)
        kh = k.astype(f32).reshape(bsz, seqlen, GLA_HEADS, GLA_DK)
        vh = v.astype(f32).reshape(bsz, seqlen, GLA_HEADS, GLA_DV)
        log_a = jax.nn.log_sigmoid((a_low @ gla_w_alpha_up[l] + gla_b_alpha[l]).astype(f32)) / GLA_GATE_NORM
        o = gla_chunked(qh, kh, vh, log_a.reshape(bsz, seqlen, GLA_HEADS, GLA_DK))
        o = o * lax.rsqrt(jnp.mean(o * o, axis=-1, keepdims=True) + GROUP_EPS)
        gla_out = o.reshape(bsz, seqlen, GLA_WIDTH) * gla_norm_w[l].astype(f32) * jax.nn.silu(g.astype(f32))

        conv = lax.conv_general_dilated(
            xbc, ssd_conv_w[l][:, None, :], window_strides=(1,), padding=[(SSD_CONV - 1, 0)],
            dimension_numbers=('NWC', 'WIO', 'NWC'), feature_group_count=SSD_CONV_CH)
        xbc_act = jax.nn.silu((conv + ssd_conv_b[l]).astype(f32))
        xs, bm, cm = jnp.split(xbc_act, [SSD_WIDTH, SSD_WIDTH + SSD_GROUPS * SSD_STATE], axis=-1)
        xs = xs.reshape(bsz, seqlen, SSD_GROUPS, SSD_HPG, SSD_HEADDIM)
        bm = bm.reshape(bsz, seqlen, SSD_GROUPS, SSD_STATE)
        cm = cm.reshape(bsz, seqlen, SSD_GROUPS, SSD_STATE)
        dt = jax.nn.softplus(dt_raw.astype(f32) + ssd_dt_bias[l].astype(f32))
        dt = dt.reshape(bsz, seqlen, SSD_GROUPS, SSD_HPG)
        a_neg = -jnp.exp(ssd_A_log[l].astype(f32)).reshape(SSD_GROUPS, SSD_HPG)
        y = ssd_chunked(xs, dt, a_neg, bm, cm)
        y = y + ssd_D[l].astype(f32).reshape(SSD_GROUPS, SSD_HPG)[..., None] * xs
        y = y.reshape(bsz, seqlen, SSD_WIDTH) * jax.nn.silu(z.astype(f32))
        yg = y.reshape(bsz, seqlen, SSD_GROUPS, SSD_WIDTH // SSD_GROUPS)
        yg = yg * lax.rsqrt(jnp.mean(yg * yg, axis=-1, keepdims=True) + GROUP_EPS)
        ssd_out = yg.reshape(bsz, seqlen, SSD_WIDTH) * ssd_norm_w[l].astype(f32)

        mixed = jnp.concatenate([gla_out, ssd_out], axis=-1).astype(x.dtype)
        x = x + mixed @ w_out[l]

        h2 = rmsnorm(x, norm_ffn_w[l])
        x = x + moe_ffn(h2, router_w[l], router_b[l], moe_w_gate[l], moe_b_gate[l],
                        moe_w_up[l], moe_b_up[l], moe_w_down[l], moe_b_down[l])
    return rmsnorm(x, final_norm_w)
```

```cpp
#include <hip/hip_runtime.h>
#include <cstdio>
#include <cstdint>

#define GAS __attribute__((address_space(1)))
#define LAS __attribute__((address_space(3)))
typedef unsigned short bf16;
typedef unsigned v4u __attribute__((ext_vector_type(4)));
typedef unsigned v2u __attribute__((ext_vector_type(2)));
typedef float f32x4 __attribute__((ext_vector_type(4)));
typedef float f32x2 __attribute__((ext_vector_type(2)));
typedef short bf16x8 __attribute__((ext_vector_type(8)));
typedef short s16x4 __attribute__((ext_vector_type(4)));
typedef int v8i __attribute__((ext_vector_type(8)));
typedef int v4i __attribute__((ext_vector_type(4)));
constexpr float YSCALE = 16.0f, YSCALE_INV = 1.0f / 16.0f;
constexpr float SGSCALE = 2.0f, SSSCALE = 8.0f;
constexpr float WSCALE = 256.0f, WSCALE_INV = 1.0f / 256.0f;
typedef GAS unsigned gu32;
#define RLX_AGENT __ATOMIC_RELAXED, __HIP_MEMORY_SCOPE_AGENT
#define DI __device__ __forceinline__

#ifndef MK_N_LAUNCHES
#define MK_N_LAUNCHES 1
#endif
#ifndef KREP7
#define KREP7 1
#endif
#ifndef EPI_TWICE
#define EPI_TWICE 0
#endif
constexpr int NPHASE = 10;
constexpr int N_LAUNCHES = MK_N_LAUNCHES;

constexpr int NB = 8, SEQ = 2048, T = NB * SEQ, D = 1024, CH = 64, NCH = SEQ / CH;
constexpr int D_IN = 3096, NPROJ = 3072;
constexpr int NE = 32, DFF = 1024;
constexpr int LISTCAP = T * 4;
constexpr int PC_Q = 0, PC_K = 256, PC_V = 512, PC_G = 1024, PC_Z = 1536, PC_XBC = 2048;

constexpr size_t MiB = 1u << 20;
constexpr size_t WS_CTL = 0, CTL_ZERO_BYTES = 32768;
constexpr size_t WS_RSTD1 = 1 * MiB, WS_RSTD2 = WS_RSTD1 + 65536, WS_GATEW = WS_RSTD2 + 65536  , WS_DECG = WS_GATEW + 262144  , WS_SDEC = WS_DECG + 262144  ;
constexpr size_t WS_WRT = 1 * MiB + 768 * 1024;
constexpr size_t WS_PART = 132 * MiB, WS_PSS = 140 * MiB;
constexpr size_t WS_EXTRA = 2 * MiB;
constexpr size_t WS_WIN = 4 * MiB, WS_WO = 10 * MiB, WS_LIST = 12 * MiB;
constexpr size_t WS_WGU = 20 * MiB  , WS_WD = 148 * MiB  ;
constexpr size_t WS_LG = 84 * MiB, WS_LS = 100 * MiB;
constexpr size_t WS_X1 = 212 * MiB, WS_X1B = 276 * MiB;
constexpr size_t WS_STG = 212 * MiB, WS_STS = 228 * MiB, WS_XBCA = 260 * MiB, WS_QKT = 292 * MiB  ;
constexpr size_t WS_XB = 308 * MiB, WS_PROJ = 340 * MiB, WS_MIXED = 436 * MiB;
constexpr size_t WS_ACT = 308 * MiB;
constexpr size_t WS_Y4 = 20 * MiB;
constexpr size_t WS_END = 512 * MiB;
constexpr int CW_TMO = 0, CW_CODE = 1, CW_CNT = 64, CW_BAR = 4096;

constexpr int RING_BYTES = 131072;
constexpr int TBL_OFF = 131072;
constexpr int MOE_OFF = TBL_OFF + 2048;
constexpr int EPI_OFF = MOE_OFF + 1024;
constexpr int LDS_BYTES = 147456;
constexpr int MISC_OFF = LDS_BYTES - 256;

DI float bf2f(unsigned v) { return __uint_as_float(v << 16); }
DI unsigned f2bf(float f) { unsigned u = __builtin_bit_cast(unsigned, f); return (u + 0x7fffu + ((u >> 16) & 1u)) >> 16; }
typedef __bf16 bf16x2_t __attribute__((ext_vector_type(2)));
DI unsigned cvt_pk_bf16(float lo, float hi) { const f32x2 v = {lo, hi}; return __builtin_bit_cast(unsigned, __builtin_convertvector(v, bf16x2_t)); }
DI float fexp(float x) { return __builtin_amdgcn_exp2f(x * 1.4426950408889634f); }
DI float flog(float x) { return __builtin_amdgcn_logf(x) * 0.6931471805599453f; }
DI float frcp(float x) { return __builtin_amdgcn_rcpf(x); }
DI float silu(float x) { return x * frcp(1.0f + fexp(-x)); }
DI float softplus(float x) { return fmaxf(x, 0.f) + flog(1.0f + fexp(-fabsf(x))); }
DI float logsigmoid(float x) { return fminf(x, 0.f) - flog(1.0f + fexp(-fabsf(x))); }
DI f32x4 mfma16(bf16x8 a, bf16x8 b, f32x4 c) { return __builtin_amdgcn_mfma_f32_16x16x32_bf16(a, b, c, 0, 0, 0); }
DI bf16x8 lds_frag(const LAS bf16* p) {
    const s16x4 a = *(const LAS s16x4*)p, b = *(const LAS s16x4*)(p + 4);
    return __builtin_shufflevector(a, b, 0, 1, 2, 3, 4, 5, 6, 7);
}
DI bf16x8 lds_frag2(const LAS bf16* p0, const LAS bf16* p1) {
    const s16x4 a = *(const LAS s16x4*)p0, b = *(const LAS s16x4*)p1;
    return __builtin_shufflevector(a, b, 0, 1, 2, 3, 4, 5, 6, 7);
}
DI f32x4 mul4(f32x4 a, float s) { const f32x2 s2 = {s, s}; const f32x2 lo = (f32x2){a.x, a.y} * s2, hi = (f32x2){a.z, a.w} * s2; return (f32x4){lo.x, lo.y, hi.x, hi.y}; }
DI f32x4 fma4(f32x4 a, float s, f32x4 b) { const f32x2 s2 = {s, s}; const f32x2 lo = (f32x2){a.x, a.y} * s2 + (f32x2){b.x, b.y}, hi = (f32x2){a.z, a.w} * s2 + (f32x2){b.z, b.w}; return (f32x4){lo.x, lo.y, hi.x, hi.y}; }
DI f32x4 add4(f32x4 a, f32x4 b) { const f32x2 lo = (f32x2){a.x, a.y} + (f32x2){b.x, b.y}, hi = (f32x2){a.z, a.w} + (f32x2){b.z, b.w}; return (f32x4){lo.x, lo.y, hi.x, hi.y}; }
DI v4u widen16(v2u a, v2u b) { const auto rx = __builtin_amdgcn_permlane16_swap(a.x, b.x, false, false); const auto ry = __builtin_amdgcn_permlane16_swap(a.y, b.y, false, false); return (v4u){rx[0], ry[0], rx[1], ry[1]}; }
DI bf16x8 pack8(f32x4 a, f32x4 b) { v4u p; p.x = cvt_pk_bf16(a.x, a.y); p.y = cvt_pk_bf16(a.z, a.w); p.z = cvt_pk_bf16(b.x, b.y); p.w = cvt_pk_bf16(b.z, b.w); return __builtin_bit_cast(bf16x8, p); }
DI v2u pack4(f32x4 a) { v2u p; p.x = cvt_pk_bf16(a.x, a.y); p.y = cvt_pk_bf16(a.z, a.w); return p; }
DI bf16x8 fp8x8_to_bf16(unsigned w0, unsigned w1, float s) {
    const f32x2 s2 = {s, s}; const f32x2 a = __builtin_amdgcn_cvt_pk_f32_fp8((int)w0, false) * s2, b = __builtin_amdgcn_cvt_pk_f32_fp8((int)w0, true) * s2, c = __builtin_amdgcn_cvt_pk_f32_fp8((int)w1, false) * s2, d = __builtin_amdgcn_cvt_pk_f32_fp8((int)w1, true) * s2;
    v4u p; p.x = cvt_pk_bf16(a.x, a.y); p.y = cvt_pk_bf16(b.x, b.y); p.z = cvt_pk_bf16(c.x, c.y); p.w = cvt_pk_bf16(d.x, d.y); return __builtin_bit_cast(bf16x8, p); }
DI float sat8(float v) { return __builtin_amdgcn_fmed3f(v, -448.0f, 448.0f); }
DI unsigned pk_fp8x4(float a, float b, float c, float d) { int w = 0; w = __builtin_amdgcn_cvt_pk_fp8_f32(a, b, w, false); w = __builtin_amdgcn_cvt_pk_fp8_f32(c, d, w, true); return (unsigned)w; }
DI float wave_incl_scan(float v, int lane) {
#pragma unroll
    for (int o = 1; o < 64; o <<= 1) { const float u = __shfl_up(v, o); if (lane >= o) v += u; }
    return v;
}

namespace pg8 {
constexpr int BM = 256, BK = 64, HALF = 128, HTB = HALF * BK * 2, NXCD = 8, WGM = 8;
DI int lds_byte(int r, int c) { const int st = (r >> 4) * 2 + (c >> 5), rr = r & 15, cc = c & 31, ob = rr * 64 + cc * 2; return st * 1024 + (ob ^ (((ob >> 9) & 1) << 5)); }
DI void stage_rc(int b, int& R, int& C) { const int st = b / 1024, sb = b % 1024, swz = sb ^ (((sb >> 9) & 1) << 5); R = (st >> 1) * 16 + swz / 64; C = (st & 1) * 32 + (swz % 64) / 2; }
DI int perm32(int rho) { const int n = rho >> 4, i = rho & 15; return 8 * (i >> 2) + 4 * n + (i & 3); }

struct Unit { int pm, pn, e, valid, rt; };

struct DenseOrder {
    const char* A; const char* Bt; int nM, nN, nwg, G, c; size_t tstep;
    DI void init(const void* A_, const void* Bt_, int M, int N, int KB, int G_, int c_) { A = (const char*)A_; Bt = (const char*)Bt_; nM = M / BM; nN = N / BM; nwg = nM * nN; G = G_; c = c_; tstep = (size_t)BM * KB; }
    DI bool next(int i, Unit& u) const {
        const long L = (long)i * G + c; if (L >= nwg) return false;
        int wgid = (int)L; { const int q = nwg / NXCD, r = nwg % NXCD, xcd = wgid % NXCD, off = wgid / NXCD; wgid = (xcd < r ? xcd * (q + 1) : r * (q + 1) + (xcd - r) * q) + off; }
        const int nig = WGM * nN, gid = wgid / nig, fm = gid * WGM, gsz = (nM - fm) < WGM ? (nM - fm) : WGM;
        u.pm = fm + ((wgid % nig) % gsz); u.pn = (wgid % nig) / gsz; u.e = 0; u.valid = 256; u.rt = 0; return true;
    }
    DI const char* a_base(const Unit& u) const { return A + (size_t)u.pm * tstep; }
    DI const char* b_base(const Unit& u) const { return Bt + (size_t)u.pn * tstep; }
    DI const int* list_ptr(const Unit&) const { return nullptr; }
};
template <int NCT, bool GATHER_A> struct MoeOrder {
    const char* A; const char* Bt; const int* list; const LAS int* PT; const LAS int* CNT; int G, c; size_t tstep, estep, astep;
    DI bool next(int i, Unit& u) const {
        const int Tt = __builtin_amdgcn_readfirstlane(PT[NE]); int tix, L;
        if ((G & 7) == 0) { const int ntx = (Tt + 7) >> 3, x = c & 7, j = i * (G >> 3) + (c >> 3), tl = j / NCT; tix = x * ntx + tl; L = j; if (tl >= ntx || tix >= Tt) return false; }
        else { L = i * G + c; tix = L / NCT; if (tix >= Tt) return false; }
        const int ln_ = (int)(threadIdx.x & 63);
        const int e = __builtin_popcountll(__ballot(ln_ < NE - 1 && PT[(ln_ < NE - 1) ? ln_ + 1 : 0] <= tix));
        u.pm = tix; u.pn = L % NCT; u.e = e; u.rt = tix - __builtin_amdgcn_readfirstlane(PT[e]); const int rem = __builtin_amdgcn_readfirstlane(CNT[e]) - u.rt * 256; u.valid = rem < 256 ? rem : 256; return true;
    }
    DI const char* a_base(const Unit& u) const { return GATHER_A ? A : A + (size_t)u.pm * astep; }
    DI const char* b_base(const Unit& u) const { return Bt + (size_t)u.e * estep + (size_t)u.pn * tstep; }
    DI const int* list_ptr(const Unit& u) const { return list + (size_t)u.e * LISTCAP + u.rt * 256; }
};

template <class Epi, class Sched, bool ALIGN_EPI, bool TABLE, bool GATHER, bool FP8, bool IDENT = false, int KREP = 1>
DI void gemm_phase(LAS unsigned char* lds, const int KB, const Sched& S, const Epi& E) {
    const int tid = threadIdx.x, wid = __builtin_amdgcn_readfirstlane(tid >> 6), lane = tid & 63, wr = wid >> 2, wc = wid & 3, fr = lane & 15, fq = lane >> 4;
    int nt = KB / 128; asm volatile("" : "+s"(nt));
    unsigned voffA[2], voffB[2]; int RA[2]; unsigned CA2[2];
#pragma unroll
    for (int i = 0; i < 2; ++i) { int R, C; stage_rc(tid * 16 + i * 8192, R, C); const int Rb = Epi::PERM ? ((R & ~31) + perm32(R & 31)) : R;
        voffA[i] = (unsigned)(R * KB + C * 2); voffB[i] = (unsigned)(Rb * KB + C * 2); RA[i] = R; CA2[i] = (unsigned)C * 2u; }
    const size_t kstep = (size_t)(BK * 2);
    const size_t hstep = (size_t)HALF * KB;
    const unsigned ldsw = (unsigned)wid * 1024u;
    const int aoff = lds_byte(wr * 64 + fr, fq * 8), boff = lds_byte(wc * 32 + fr, fq * 8);
    unsigned vA[2][2];
#define PG8_SA(b, h) (((b) * 2 + (h)) * HTB)
#define PG8_SB(b, h) ((4 + (b) * 2 + (h)) * HTB)
#define PG8_STAGE(bufoff, gbase, voff) do { _Pragma("unroll") for (int _i = 0; _i < 2; ++_i) \
        __builtin_amdgcn_global_load_lds((const unsigned*)((const char*)(gbase) + (voff)[_i]), (LAS unsigned*)(lds + (bufoff) + ldsw + _i * 8192), 16, 0, 0); } while (0)
#define PG8_STAGE_A(bufoff, gp, h, nx) PG8_STAGE(bufoff, gp, vA[h])
#define PG8_LDA(dst, b, h) do { _Pragma("unroll") for (int m = 0; m < 4; ++m) { \
        if constexpr (FP8) dst##8[m] = PG8_CAT(*(const LAS v4i*)(lds + PG8_SA(b, h) + aoff + m * 2048), *(const LAS v4i*)(lds + PG8_SA(b, h) + aoff + m * 2048 + 1024)); \
        else { _Pragma("unroll") for (int k = 0; k < 2; ++k) dst[m][k] = *(const LAS bf16x8*)(lds + PG8_SA(b, h) + aoff + m * 2048 + k * 1024); } } } while (0)
#define PG8_LDB(dst, b, h) do { _Pragma("unroll") for (int n = 0; n < 2; ++n) { \
        if constexpr (FP8) dst##8[n] = PG8_CAT(*(const LAS v4i*)(lds + PG8_SB(b, h) + boff + n * 2048), *(const LAS v4i*)(lds + PG8_SB(b, h) + boff + n * 2048 + 1024)); \
        else { _Pragma("unroll") for (int k = 0; k < 2; ++k) dst[n][k] = *(const LAS bf16x8*)(lds + PG8_SB(b, h) + boff + n * 2048 + k * 1024); } } } while (0)
#define PG8_CAT(x0, x1) __builtin_shufflevector(x0, x1, 0, 1, 2, 3, 4, 5, 6, 7)
#define PG8_MMA(ai, bj, At, Bt) do { __builtin_amdgcn_s_setprio(1); _Pragma("unroll") for (int m = 0; m < 4; ++m) _Pragma("unroll") for (int n = 0; n < 2; ++n) { \
        if constexpr (FP8) acc[ai][bj][m][n] = __builtin_amdgcn_mfma_scale_f32_16x16x128_f8f6f4(Bt##8[n], At##8[m], acc[ai][bj][m][n], 0, 0, 0, 0x7f7f7f7f, 0, 0x7f7f7f7f); \
        else { _Pragma("unroll") for (int k = 0; k < 2; ++k) acc[ai][bj][m][n] = __builtin_amdgcn_mfma_f32_16x16x32_bf16(Bt[n][k], At[m][k], acc[ai][bj][m][n], 0, 0, 0); } } \
        __builtin_amdgcn_s_setprio(0); } while (0)
#define PG8_WAIT_V(n) asm volatile("s_waitcnt vmcnt(" #n ")" ::: "memory")
#define PG8_WAIT_VR(n, r) asm volatile("s_cmp_lg_u32 %0, 0\n\ts_cbranch_scc1 .Lpg8a%=\n\ts_waitcnt vmcnt(" #n ")\n\ts_branch .Lpg8b%=\n.Lpg8a%=:\n\ts_waitcnt vmcnt(%1)\n.Lpg8b%=:" :: "s"(rel), "n"(r) : "scc", "memory")
#define PG8_WAIT_L(n) asm volatile("s_waitcnt lgkmcnt(" #n ")" ::: "memory")
#define PG8_BAR __builtin_amdgcn_s_barrier()
#define PG8_SCHED __builtin_amdgcn_sched_barrier(0)
#define PG8_ROWS1(h, par, vld) do { const LAS int* _tb = (const LAS int*)(lds + TBL_OFF + (par) * 1024); _Pragma("unroll") for (int _i = 0; _i < 2; ++_i) { \
        const int _r = (h) * HALF + RA[_i]; const int _s = _tb[_r]; unsigned _tok = (_r < (vld)) ? ((unsigned)_s >> 2) : 0u; if constexpr (IDENT) _tok = (unsigned)_r + ((unsigned)_s & 0u); vA[h][_i] = _tok * (unsigned)KB + CA2[_i]; } } while (0)
#define PG8_TBL_DMA(lp, par) do { if (wid == 0) { int ln_ = (int)threadIdx.x; asm volatile("" : "+v"(ln_)); __builtin_amdgcn_global_load_lds((const unsigned*)((const int*)(lp) + ln_ * 4), (LAS unsigned*)(lds + TBL_OFF + (par) * 1024), 16, 0, 0); } } while (0)
    if constexpr (!GATHER) {
#pragma unroll
        for (int i = 0; i < 2; ++i) { vA[0][i] = voffA[i]; vA[1][i] = voffA[i] + (unsigned)hstep; } }
    Unit cur, nxt; int ui = 0;
    if (!S.next(0, cur)) return;
    f32x4 acc[2][2][4][2];
#pragma unroll
    for (int a = 0; a < 2; ++a)
#pragma unroll
        for (int b = 0; b < 2; ++b)
#pragma unroll
            for (int m = 0; m < 4; ++m)
#pragma unroll
                for (int n = 0; n < 2; ++n) acc[a][b][m][n] = (f32x4){0.f, 0.f, 0.f, 0.f};
    bf16x8 At[4][2], B0[2][2], B1[2][2]; v8i At8[4], B08[2], B18[2];
    const char* cA = S.a_base(cur); const char* cB = S.b_base(cur);
    if constexpr (TABLE) {
        PG8_TBL_DMA(S.list_ptr(cur), 0); PG8_STAGE(PG8_SB(0, 0), cB, voffB); PG8_STAGE(PG8_SB(0, 1), cB + hstep, voffB);
        PG8_WAIT_V(4); PG8_BAR; asm volatile("" ::: "memory");
        if constexpr (GATHER) { PG8_ROWS1(0, 0, cur.valid); PG8_ROWS1(1, 0, cur.valid); }
    }
    if constexpr (!TABLE) { PG8_STAGE(PG8_SB(0, 0), cB, voffB); PG8_STAGE(PG8_SB(0, 1), cB + hstep, voffB); }
    PG8_STAGE_A(PG8_SA(0, 0), cA, 0, false); PG8_STAGE_A(PG8_SA(0, 1), cA, 1, false);
    if (wr == 1) PG8_BAR;
    PG8_WAIT_V(2); PG8_BAR;
    PG8_STAGE(PG8_SB(1, 0), cB + kstep, voffB); PG8_STAGE_A(PG8_SA(1, 0), cA + kstep, 0, false); PG8_STAGE(PG8_SB(1, 1), cB + hstep + kstep, voffB);
    PG8_WAIT_V(6); PG8_BAR;
    for (;;) {
        const bool has_next = S.next(ui + 1, nxt);
        const char* nA = has_next ? S.a_base(nxt) : cA; const char* nB = has_next ? S.b_base(nxt) : cB;
        const int nvalid = has_next ? nxt.valid : cur.valid;
#pragma unroll 1
        for (int t0_ = 0; t0_ < nt * KREP; t0_ += 2) {
            const int t = (KREP == 1) ? t0_ : (t0_ % nt);
            const bool last = (t0_ == nt * KREP - 2);
            int rel = (Epi::NST >= 0 && KREP == 1 && ui > 0 && t0_ == 0 && nt > 4) ? 1 : 0; rel = __builtin_amdgcn_readfirstlane(rel); asm volatile("" : "+s"(rel));
            asm volatile("" : "+v"(vA[0][0]), "+v"(vA[0][1]), "+v"(vA[1][0]), "+v"(vA[1][1]), "+v"(voffB[0]), "+v"(voffB[1]));
            if constexpr (TABLE) { if (t0_ == nt * KREP - 4 && has_next) PG8_TBL_DMA(S.list_ptr(nxt), (ui + 1) & 1); }
            if constexpr (Epi::PREFETCH) { if (t0_ == 0) { const float* gp_ = E.pf_addr(cur, (const LAS int*)(lds + TBL_OFF + (ui & 1) * 1024));
                    if (wid < Epi::PF_WAVES) __builtin_amdgcn_global_load_lds((const unsigned*)gp_, (LAS unsigned*)(lds + EPI_OFF + (ui & 1) * 2048 + wid * 256), 4, 0, 0); } }
            const char* a1 = cA + (size_t)(t + 1) * kstep;
            const int t2_ = (KREP == 1) ? t + 2 : ((t + 2) % nt);
            const char* a2 = last ? nA : cA + (size_t)t2_ * kstep; const char* b2 = last ? nB : cB + (size_t)t2_ * kstep;
            const char* a3 = a2 + kstep; const char* b3 = b2 + kstep;
            if constexpr (GATHER) { if (last && has_next) { PG8_ROWS1(0, (ui + 1) & 1, nvalid); } }
            PG8_LDB(B0, 0, 0); PG8_LDB(B1, 0, 1); PG8_SCHED; PG8_LDA(At, 0, 0); PG8_STAGE_A(PG8_SA(1, 1), a1, 1, false);
            if constexpr (GATHER) { if (last && has_next) { PG8_ROWS1(1, (ui + 1) & 1, nvalid); } }
            PG8_WAIT_VR(8, 8 + Epi::NST); PG8_WAIT_L(0); PG8_BAR; PG8_MMA(0, 0, At, B0); PG8_MMA(0, 1, At, B1); PG8_BAR; PG8_SCHED;
            PG8_LDA(At, 0, 1); PG8_STAGE(PG8_SB(0, 0), b2, voffB); PG8_STAGE(PG8_SB(0, 1), b2 + hstep, voffB); PG8_STAGE_A(PG8_SA(0, 0), a2, 0, last);
            PG8_WAIT_VR(8, 8 + Epi::NST); PG8_WAIT_L(0); PG8_BAR; PG8_MMA(1, 0, At, B0); PG8_MMA(1, 1, At, B1); PG8_BAR; PG8_SCHED;
            PG8_LDB(B0, 1, 0); PG8_LDB(B1, 1, 1); PG8_SCHED; PG8_LDA(At, 1, 0); PG8_STAGE_A(PG8_SA(0, 1), a2, 1, last);
            PG8_WAIT_VR(8, 10 + Epi::NST); PG8_WAIT_L(0); PG8_BAR; PG8_MMA(0, 0, At, B0); PG8_MMA(0, 1, At, B1); PG8_BAR; PG8_SCHED;
            PG8_LDA(At, 1, 1); PG8_STAGE(PG8_SB(1, 0), b3, voffB); PG8_STAGE(PG8_SB(1, 1), b3 + hstep, voffB); PG8_STAGE_A(PG8_SA(1, 0), a3, 0, last);
            PG8_WAIT_VR(8, 14); PG8_WAIT_L(0); PG8_BAR; PG8_MMA(1, 0, At, B0); PG8_MMA(1, 1, At, B1); PG8_BAR; PG8_SCHED;
        }
        if constexpr (ALIGN_EPI) { if (wr == 0) PG8_BAR; }
        if constexpr (!Epi::AFTER_DRAIN) E(acc, cur, wr, wc, fr, fq, (const LAS int*)(lds + TBL_OFF + (ui & 1) * 1024), (const LAS float*)(lds + EPI_OFF + (ui & 1) * 2048));
        if (!has_next) break;
#pragma unroll
        for (int a = 0; a < 2; ++a)
#pragma unroll
            for (int b = 0; b < 2; ++b)
#pragma unroll
                for (int m = 0; m < 4; ++m)
#pragma unroll
                    for (int n = 0; n < 2; ++n) acc[a][b][m][n] = (f32x4){0.f, 0.f, 0.f, 0.f};
        cur = nxt; cA = nA; cB = nB; ++ui;
        if constexpr (ALIGN_EPI) { if (wr == 1) PG8_BAR; }
    }
    PG8_WAIT_V(0);
    if constexpr (!ALIGN_EPI) { if (wr == 0) PG8_BAR; }
    PG8_BAR;
    if constexpr (Epi::AFTER_DRAIN) E.drain(acc, cur, wr, wc, fr, fq, lds);
#undef PG8_SA
#undef PG8_SB
#undef PG8_STAGE
#undef PG8_STAGE_A
#undef PG8_LDA
#undef PG8_LDB
#undef PG8_MMA
#undef PG8_CAT
#undef PG8_WAIT_V
#undef PG8_WAIT_VR
#undef PG8_WAIT_L
#undef PG8_BAR
#undef PG8_SCHED
#undef PG8_ROWS1
#undef PG8_TBL_DMA
}

struct EpiProj {
    static constexpr bool PERM = true, AFTER_DRAIN = false, PREFETCH = true; static constexpr int PF_WAVES = 4, NST = 16;
    bf16* O; const float* rstd;
    DI const float* pf_addr(const Unit& u, const LAS int*) const { return rstd + u.pm * BM + ((int)threadIdx.x & 255); }
    DI void operator()(const f32x4 (&acc)[2][2][4][2], const Unit& u, int wr, int wc, int fr, int fq, const LAS int*, const LAS float* ep) const {
        { int ln_ = (int)threadIdx.x; asm volatile("" : "+v"(ln_)); fr = ln_ & 15; fq = (ln_ >> 4) & 3; }
        const int row0 = u.pm * BM + wr * 64 + fr, col0 = u.pn * BM + wc * 32 + 8 * fq;
#pragma unroll
        for (int ai = 0; ai < 2; ++ai)
#pragma unroll
            for (int m = 0; m < 4; ++m) { const int row = row0 + ai * HALF + m * 16; const float rs = ep[wr * 64 + fr + ai * HALF + m * 16]; bf16* rowp = O + (size_t)row * NPROJ + col0;
#pragma unroll
                for (int bj = 0; bj < 2; ++bj) { const f32x4 v0 = mul4(acc[ai][bj][m][0], rs), v1 = mul4(acc[ai][bj][m][1], rs);
                    v4u w; w.x = cvt_pk_bf16(v0[0], v0[1]); w.y = cvt_pk_bf16(v0[2], v0[3]); w.z = cvt_pk_bf16(v1[0], v1[1]); w.w = cvt_pk_bf16(v1[2], v1[3]);
                    *(v4u*)(rowp + bj * HALF) = w; } }
    }
};
struct EpiX1 {
    static constexpr bool PERM = true, AFTER_DRAIN = false, PREFETCH = false; static constexpr int NST = -1;
    const float* x; bf16* X1; unsigned char* X1Q;
    DI void operator()(const f32x4 (&acc)[2][2][4][2], const Unit& u, int wr, int wc, int fr, int fq, const LAS int*, const LAS float*) const {
        { int ln_ = (int)threadIdx.x; asm volatile("" : "+v"(ln_)); fr = ln_ & 15; fq = (ln_ >> 4) & 3; }
        const int row0 = u.pm * BM + wr * 64 + fr, col0 = u.pn * BM + wc * 32 + 8 * fq;
#pragma unroll
        for (int ai = 0; ai < 2; ++ai)
#pragma unroll
            for (int m = 0; m < 4; ++m) { const size_t off = (size_t)(row0 + ai * HALF + m * 16) * D + col0;
#pragma unroll
                for (int bj = 0; bj < 2; ++bj) { const f32x4 o0 = add4(*(const f32x4*)(x + off + bj * HALF), acc[ai][bj][m][0]), o1 = add4(*(const f32x4*)(x + off + bj * HALF + 4), acc[ai][bj][m][1]);
                    *(v4u*)(X1 + off + bj * HALF) = __builtin_bit_cast(v4u, pack8(o0, o1));
                    v2u w; w.x = pk_fp8x4(o0.x, o0.y, o0.z, o0.w); w.y = pk_fp8x4(o1.x, o1.y, o1.z, o1.w); *(v2u*)(X1Q + off + bj * HALF) = w; }
                if (m & 1) asm volatile("" ::: "memory"); }
    }
};
struct EpiX1R {
    static constexpr bool PERM = true, AFTER_DRAIN = true, PREFETCH = false; static constexpr int NST = -1;
    const float* x; bf16* X1; unsigned char* X1Q; const bf16* WRT; float* PART; float* PSS;
    DI void drain(const f32x4 (&acc)[2][2][4][2], const Unit& u, int wr, int wc, int fr, int fq, LAS unsigned char* lds) const {
        { int ln_ = (int)threadIdx.x; asm volatile("" : "+v"(ln_)); fr = ln_ & 15; fq = (ln_ >> 4) & 3; }
        LAS float* LG = (LAS float*)lds + wc * (256 * 33); LAS float* SS = (LAS float*)lds + 4 * 256 * 33 + wc * 256;
        const int row0 = u.pm * BM + wr * 64 + fr, col0 = u.pn * BM + wc * 32 + 8 * fq;
        bf16x8 Bw[2][4];
#pragma unroll
        for (int bj = 0; bj < 2; ++bj) { const bf16* wp = WRT + (size_t)fr * D + col0 + bj * HALF;
            Bw[bj][0] = __builtin_bit_cast(bf16x8, *(const v4u*)(wp)); Bw[bj][1] = __builtin_bit_cast(bf16x8, *(const v4u*)(wp + 32 * D));
            Bw[bj][2] = __builtin_bit_cast(bf16x8, *(const v4u*)(wp + 16 * D)); Bw[bj][3] = __builtin_bit_cast(bf16x8, *(const v4u*)(wp + 48 * D)); }
        f32x4 xq[8][4];
#define X1R_LOADX(i) do { const size_t off_ = (size_t)(row0 + ((i) >> 2) * HALF + ((i) & 3) * 16) * D + col0; xq[i][0] = *(const f32x4*)(x + off_); xq[i][1] = *(const f32x4*)(x + off_ + 4); xq[i][2] = *(const f32x4*)(x + off_ + HALF); xq[i][3] = *(const f32x4*)(x + off_ + HALF + 4); } while (0)
        X1R_LOADX(0); X1R_LOADX(1);
        __syncthreads();
        v2u wq_[2] = {{0u, 0u}, {0u, 0u}};
#pragma unroll
        for (int ai = 0; ai < 2; ++ai)
#pragma unroll
            for (int m = 0; m < 4; ++m) { const size_t off = (size_t)(row0 + ai * HALF + m * 16) * D + col0; f32x4 t0 = {0.f, 0.f, 0.f, 0.f}, t1 = t0; float ss = 0.f;
                if (ai * 4 + m + 2 < 8) X1R_LOADX(ai * 4 + m + 2);
#pragma unroll
                for (int bj = 0; bj < 2; ++bj) { const f32x4 o0 = add4(xq[ai * 4 + m][2 * bj], acc[ai][bj][m][0]), o1 = add4(xq[ai * 4 + m][2 * bj + 1], acc[ai][bj][m][1]);
                    const bf16x8 A = pack8(o0, o1); const v4u aw = __builtin_bit_cast(v4u, A);
                    *(v4u*)(X1 + off + bj * HALF) = aw;
                    v2u w; w.x = pk_fp8x4(o0.x, o0.y, o0.z, o0.w); w.y = pk_fp8x4(o1.x, o1.y, o1.z, o1.w);
                    if (m & 1) { const int odd_ = fq & 1; *(v4u*)(X1Q + off - (size_t)(16 - 16 * odd_) * D - 8 * odd_ + bj * HALF) = widen16(wq_[bj], w); } else wq_[bj] = w;
#pragma unroll
                    for (int e = 0; e < 4; ++e) { const float lo = bf2f(aw[e] & 0xffffu), hi = bf2f(aw[e] >> 16); ss += lo * lo + hi * hi; }
                    t0 = mfma16(A, Bw[bj][0], t0); t0 = mfma16(A, Bw[bj][1], t0); t1 = mfma16(A, Bw[bj][2], t1); t1 = mfma16(A, Bw[bj][3], t1); }
                ss += __shfl_xor(ss, 16); ss += __shfl_xor(ss, 32);
                const int rl = ai * HALF + wr * 64 + m * 16;
                if (fq == 0) SS[rl + fr] = ss;
#pragma unroll
                for (int v = 0; v < 4; ++v) { LG[(rl + 4 * fq + v) * 33 + fr] = t0[v]; LG[(rl + 4 * fq + v) * 33 + 16 + fr] = t1[v]; }
                asm volatile("" ::: "memory"); }
#undef X1R_LOADX
        __syncthreads();
        {   const int t = (int)threadIdx.x, row = t >> 1, hf = t & 1; float* dst = PART + ((size_t)u.pn * T + (size_t)u.pm * BM + row) * 32 + 16 * hf; const LAS float* s = (const LAS float*)lds + row * 33 + 16 * hf;
#pragma unroll
            for (int i = 0; i < 4; ++i) { f32x4 a_;
#pragma unroll
                for (int e = 0; e < 4; ++e) a_[e] = (s[4 * i + e] + s[256 * 33 + 4 * i + e]) + (s[2 * 256 * 33 + 4 * i + e] + s[3 * 256 * 33 + 4 * i + e]);
                *(f32x4*)(dst + 4 * i) = a_; }
            const LAS float* sq = (const LAS float*)lds + 4 * 256 * 33;
            if (t < 256) PSS[(size_t)u.pn * T + (size_t)u.pm * BM + t] = (sq[t] + sq[256 + t]) + (sq[512 + t] + sq[768 + t]); }
        __syncthreads();
    }
};
struct EpiAct {
    static constexpr bool PERM = true, AFTER_DRAIN = false, PREFETCH = true; static constexpr int PF_WAVES = 8, NST = 4;
    unsigned char* ACT; const float* rstd2; const float* bgate; const float* bup;
    DI const float* pf_addr(const Unit& u, const LAS int* tb) const { const int t = (int)threadIdx.x;
        if (t < 256) { const int slot = tb[t]; const int tok = (t < u.valid) ? (slot >> 2) : 0; return rstd2 + tok; }
        const int j = t - 256; return (j < HALF ? bgate : bup) + ((size_t)u.e * DFF + u.pn * HALF + (j & (HALF - 1))); }
    DI void operator()(const f32x4 (&acc)[2][2][4][2], const Unit& u, int wr, int wc, int fr, int fq, const LAS int* tb, const LAS float* ep) const {
        { int ln_ = (int)threadIdx.x; asm volatile("" : "+v"(ln_)); fr = ln_ & 15; fq = (ln_ >> 4) & 3; }
        const int c = u.pn * HALF + wc * 32 + 8 * fq;
        const LAS float* bgp = ep + 256 + wc * 32 + 8 * fq; const LAS float* bup_ = bgp + HALF;
        constexpr float C1 = -1.702f * 1.4426950408889634f, C1I = 1.0f / C1;
        const f32x4 bg0 = *(const LAS f32x4*)bgp * C1, bg1 = *(const LAS f32x4*)(bgp + 4) * C1, bu0 = (*(const LAS f32x4*)bup_ + 1.0f) * C1I, bu1 = (*(const LAS f32x4*)(bup_ + 4) + 1.0f) * C1I;
        const int odd = fq & 1; v2u wprev = {0u, 0u};
#pragma unroll
        for (int ai = 0; ai < 2; ++ai)
#pragma unroll
            for (int m = 0; m < 4; ++m) { const int r = ai * HALF + wr * 64 + m * 16 + fr; const float rs = ep[r] * (WSCALE_INV / KREP7);
                f32x4 o[2];
#pragma unroll
                for (int n = 0; n < 2; ++n) { const f32x4 ga = acc[ai][0][m][n], ua = acc[ai][1][m][n], bgv = n ? bg1 : bg0, buv = n ? bu1 : bu0;
#pragma unroll
                    for (int h = 0; h < 2; ++h) { const f32x2 rsT = {rs * C1, rs * C1}, rsU = {rs * C1I, rs * C1I};
                        f32x2 t = (f32x2){ga[2 * h], ga[2 * h + 1]} * rsT + (f32x2){bgv[2 * h], bgv[2 * h + 1]}, u = (f32x2){ua[2 * h], ua[2 * h + 1]} * rsU + (f32x2){buv[2 * h], buv[2 * h + 1]};
                        t.x = fmaxf(t.x, 7.0f * C1); t.y = fmaxf(t.y, 7.0f * C1);
                        u.x = fminf(fmaxf(u.x, 8.0f * C1I), -6.0f * C1I); u.y = fminf(fmaxf(u.y, 8.0f * C1I), -6.0f * C1I);
                        f32x2 d; d.x = __builtin_amdgcn_exp2f(t.x); d.y = __builtin_amdgcn_exp2f(t.y); d = d + 1.0f;
                        f32x2 r; r.x = frcp(d.x); r.y = frcp(d.y);
                        const f32x2 ov = (u * t) * r; o[n][2 * h] = ov.x; o[n][2 * h + 1] = ov.y; } }
                v2u w; w.x = pk_fp8x4(o[0].x, o[0].y, o[0].z, o[0].w); w.y = pk_fp8x4(o[1].x, o[1].y, o[1].z, o[1].w);
                if (m & 1) { const v4u ww = widen16(wprev, w); *(v4u*)(ACT + ((size_t)u.pm * BM + r - 16 + 16 * odd) * DFF + c - 8 * odd) = ww; }
                else wprev = w; }
    }
};
struct EpiDown {
    static constexpr bool PERM = true, AFTER_DRAIN = false, PREFETCH = true; static constexpr int PF_WAVES = 8, NST = 0;
    unsigned char* Y4; const float* gatew; const float* bdown;
    DI const float* pf_addr(const Unit& u, const LAS int* tb) const { const int t = (int)threadIdx.x;
        if (t < 256) { const int slot = tb[t]; return gatew + (t < u.valid ? slot : 0); }
        return bdown + ((size_t)u.e * D + u.pn * BM + (t - 256)); }
    DI void operator()(const f32x4 (&acc)[2][2][4][2], const Unit& u, int wr, int wc, int fr, int fq, const LAS int* tb, const LAS float* ep) const {
        { int ln_ = (int)threadIdx.x; asm volatile("" : "+v"(ln_)); fr = ln_ & 15; fq = (ln_ >> 4) & 3; }
        const int c = u.pn * BM + wc * 32 + 8 * fq; const LAS float* bp = ep + 256 + wc * 32 + 8 * fq;
        f32x4 bd[2][2];
#pragma unroll
        for (int bj = 0; bj < 2; ++bj) { bd[bj][0] = *(const LAS f32x4*)(bp + bj * HALF); bd[bj][1] = *(const LAS f32x4*)(bp + bj * HALF + 4); }
        const int odd = fq & 1;
#pragma unroll
        for (int ai = 0; ai < 2; ++ai)
#pragma unroll
            for (int mp = 0; mp < 2; ++mp) { const int rA = ai * HALF + wr * 64 + (2 * mp) * 16 + fr, rB = rA + 16; const int sA = tb[rA], sB = tb[rB];
                const float gA = rA < u.valid ? ep[rA] * YSCALE : 0.f, gB = rB < u.valid ? ep[rB] * YSCALE : 0.f;
                const int rS = odd ? rB : rA, sS = odd ? sB : sA;
#pragma unroll
                for (int bj = 0; bj < 2; ++bj) {
                    const f32x4 a0 = mul4(fma4(acc[ai][bj][2 * mp][0], WSCALE_INV, bd[bj][0]), gA), a1 = mul4(fma4(acc[ai][bj][2 * mp][1], WSCALE_INV, bd[bj][1]), gA);
                    const f32x4 b0 = mul4(fma4(acc[ai][bj][2 * mp + 1][0], WSCALE_INV, bd[bj][0]), gB), b1 = mul4(fma4(acc[ai][bj][2 * mp + 1][1], WSCALE_INV, bd[bj][1]), gB);
                    const v4u w = widen16((v2u){pk_fp8x4(a0.x, a0.y, a0.z, a0.w), pk_fp8x4(a1.x, a1.y, a1.z, a1.w)}, (v2u){pk_fp8x4(b0.x, b0.y, b0.z, b0.w), pk_fp8x4(b1.x, b1.y, b1.z, b1.w)});
                    if (rS < u.valid) *(v4u*)(Y4 + (size_t)sS * D + c - 8 * odd + bj * HALF) = w; } }
    }
};
}

#define XB_TMO      128
#define XB_XCNT(j)  (256  + 64 * (j))
#define XB_XSUB(j)  (1280 + 64 * (j))
#define XB_XGEN(j)  (2304 + 64 * (j))
#define XB_TOP      3328
#define XB_TOPGEN   3392
#define XCD_BAR_WORDS 3456
#define XB_SPIN_CAP (1u << 18)
DI unsigned xb_ld(unsigned* p)              { return __hip_atomic_load(p, __ATOMIC_RELAXED, __HIP_MEMORY_SCOPE_AGENT); }
DI unsigned xb_add(unsigned* p, unsigned v) { return __hip_atomic_fetch_add(p, v, __ATOMIC_RELAXED, __HIP_MEMORY_SCOPE_AGENT); }
DI unsigned xb_xcc_id() { return (unsigned)__builtin_amdgcn_s_getreg((3 << 11) | 20) & 0xFu; }
#define XB_SPIN(cond, bar) do { unsigned _sp = 0; while (cond) { __builtin_amdgcn_s_sleep(1); \
    if ((++_sp & 255u) == 0u) { if (xb_ld(&(bar)[XB_TMO])) break; if (_sp > XB_SPIN_CAP) { atomicAdd(&(bar)[XB_TMO], 1u); break; } } } } while (0)
struct XcdBarrier { unsigned* bar; unsigned x; volatile LAS unsigned* st; };
DI XcdBarrier xcd_barrier_post(unsigned* bar, volatile LAS unsigned* st) {
    XcdBarrier b; b.bar = bar; b.x = xb_xcc_id(); b.st = st;
    if (threadIdx.x == 0) (void)xb_add(&bar[XB_XCNT(b.x)], 1u);
    return b;
}
DI void xcd_barrier_complete(unsigned* bar, unsigned x, unsigned& nloc, unsigned& nx) {
    const unsigned G = gridDim.x * gridDim.y * gridDim.z;
    unsigned sum, cnt, mine, sp = 0u;
    for (;;) {
        sum = 0u; cnt = 0u; mine = 0u;
#pragma unroll
        for (unsigned j = 0; j < 16; ++j) { const unsigned c = xb_ld(&bar[XB_XCNT(j)]); sum += c; cnt += (c > 0u) ? 1u : 0u; mine = (j == x) ? c : mine; }
        if (sum == G) break;
        __builtin_amdgcn_s_sleep(1);
        if ((++sp & 255u) == 0u) { if (xb_ld(&bar[XB_TMO])) break; if (sp > XB_SPIN_CAP) { atomicAdd(&bar[XB_TMO], 1u); break; } }
    }
    nloc = mine > 0u ? mine : 1u; nx = cnt > 0u ? cnt : 1u;
}
DI void xcd_barrier(const XcdBarrier& b) {
    asm volatile("s_waitcnt vmcnt(0)" ::: "memory");
    __syncthreads();
    if (threadIdx.x == 0) {
        unsigned* bar = b.bar;
        __builtin_amdgcn_s_waitcnt(0);
        unsigned nloc = b.st[0], nx = b.st[1];
        if (nloc == 0u) { xcd_barrier_complete(bar, b.x, nloc, nx); b.st[0] = nloc; b.st[1] = nx; }
        const unsigned old = xb_add(&bar[XB_XSUB(b.x)], 1u);
        const unsigned gen = old / nloc;
        if (old + 1u == (gen + 1u) * nloc) {
            __builtin_amdgcn_fence(__ATOMIC_RELEASE, "agent");
            asm volatile("s_waitcnt vmcnt(0)" ::: "memory");
            const unsigned og = xb_add(&bar[XB_TOP], 1u);
            const unsigned tg = og / nx;
            if (og + 1u == (tg + 1u) * nx) xb_add(&bar[XB_TOPGEN], 1u);
            else XB_SPIN(xb_ld(&bar[XB_TOPGEN]) == tg, bar);
            __builtin_amdgcn_fence(__ATOMIC_ACQUIRE, "agent");
            xb_add(&bar[XB_XGEN(b.x)], 1u);
            asm volatile("s_waitcnt vmcnt(0)" ::: "memory");
        } else {
            XB_SPIN(xb_ld(&bar[XB_XGEN(b.x)]) == gen, bar);
            __builtin_amdgcn_fence(__ATOMIC_ACQUIRE, "agent");
            asm volatile("s_waitcnt vmcnt(0)" ::: "memory");
        }
    }
    __syncthreads();
}

struct Args { const float* in[23]; float* out; unsigned char* ws; int ph_lo, ph_hi; };
enum { I_X = 0, I_NMIX, I_WIN, I_WAUP, I_BA, I_GNW, I_CW, I_CB, I_DTB, I_ALOG, I_DSSD, I_SNW, I_WOUT, I_NFFN, I_RW, I_RB, I_WG, I_BG, I_WU, I_BU, I_WD, I_BD, I_FNW };

struct Frame {
    LAS unsigned char* lds; int tid, lane, wave, G, bid;
    const float* const* in; float* out; unsigned char* ws;
};
#define WSP(T_, off) ((T_*)(F.ws + (off)))
#define LDS_WAIT() asm volatile("s_waitcnt lgkmcnt(0)" ::: "memory")

struct TrItem { const float* src; int sc; bf16* dst; unsigned char* dst8; int ldw, K; };
DI void tr_load(const TrItem& t, f32x4 (&r)[16], int lane) {
    const float* p = t.src + (size_t)(lane >> 3) * t.ldw + 4 * (lane & 7);
#pragma unroll
    for (int i = 0; i < 8; ++i) r[i] = __builtin_nontemporal_load((const f32x4*)(p + (size_t)(8 * i) * t.ldw));
    if (t.dst8) {
#pragma unroll
        for (int i = 8; i < 16; ++i) r[i] = __builtin_nontemporal_load((const f32x4*)(p + (size_t)(8 * i) * t.ldw)); }
}
DI void tr_store(const TrItem& t, const f32x4 (&r)[16], LAS float* scr, const LAS float* scl, int lane) {
    if (t.dst8) {
#pragma unroll
        for (int i = 0; i < 16; ++i) { LAS float* s = scr + (8 * i + (lane >> 3)) * 33 + 4 * (lane & 7); s[0] = r[i].x; s[1] = r[i].y; s[2] = r[i].z; s[3] = r[i].w; }
        LDS_WAIT(); asm volatile("" ::: "memory");
        const int c8 = lane & 7; f32x4 sc[4];
#pragma unroll
        for (int i = 0; i < 4; ++i) { sc[i] = (f32x4){WSCALE, WSCALE, WSCALE, WSCALE}; if (t.sc >= 0) sc[i] = *(const LAS f32x4*)(scl + t.sc + 16 * c8 + 4 * i); }
#pragma unroll
        for (int j = 0; j < 4; ++j) { const int n = (lane >> 3) + 8 * j; const LAS float* s = scr + (16 * c8) * 33 + n; v4u o;
            o.x = pk_fp8x4(s[0 * 33] * sc[0].x, s[1 * 33] * sc[0].y, s[2 * 33] * sc[0].z, s[3 * 33] * sc[0].w);
            o.y = pk_fp8x4(s[4 * 33] * sc[1].x, s[5 * 33] * sc[1].y, s[6 * 33] * sc[1].z, s[7 * 33] * sc[1].w);
            o.z = pk_fp8x4(s[8 * 33] * sc[2].x, s[9 * 33] * sc[2].y, s[10 * 33] * sc[2].z, s[11 * 33] * sc[2].w);
            o.w = pk_fp8x4(s[12 * 33] * sc[3].x, s[13 * 33] * sc[3].y, s[14 * 33] * sc[3].z, s[15 * 33] * sc[3].w);
            *(v4u*)(t.dst8 + (size_t)n * t.K + 16 * c8) = o; }
        LDS_WAIT(); asm volatile("" ::: "memory"); return; }
#pragma unroll
    for (int i = 0; i < 8; ++i) { LAS float* s = scr + (8 * i + (lane >> 3)) * 33 + 4 * (lane & 7); s[0] = r[i].x; s[1] = r[i].y; s[2] = r[i].z; s[3] = r[i].w; }
    LDS_WAIT(); asm volatile("" ::: "memory");
    const int c = lane & 7;
    f32x4 s0 = {1.f, 1.f, 1.f, 1.f}, s1 = s0;
    if (t.sc >= 0) { s0 = *(const LAS f32x4*)(scl + t.sc + 8 * c); s1 = *(const LAS f32x4*)(scl + t.sc + 8 * c + 4); }
#pragma unroll
    for (int j = 0; j < 4; ++j) { const int n = (lane >> 3) + 8 * j; const LAS float* s = scr + (8 * c) * 33 + n;
        v4u o; o.x = cvt_pk_bf16(s[0 * 33] * s0.x, s[1 * 33] * s0.y); o.y = cvt_pk_bf16(s[2 * 33] * s0.z, s[3 * 33] * s0.w); o.z = cvt_pk_bf16(s[4 * 33] * s1.x, s[5 * 33] * s1.y); o.w = cvt_pk_bf16(s[6 * 33] * s1.z, s[7 * 33] * s1.w);
        *(v4u*)(t.dst + (size_t)n * t.K + 8 * c) = o; }
    LDS_WAIT(); asm volatile("" ::: "memory");
}
constexpr int P0_SCR_BYTES = 128 * 33 * 4;
constexpr int P0_WX_OFF = 0, P0_WXS = 1032;
constexpr int P0_SCL_OFF = 8 * P0_SCR_BYTES;
static_assert(P0_SCL_OFF + 8192 <= MISC_OFF, "P0 LDS layout");
constexpr int P0_I_IN = 16 * 96, P0_I_O = 16 * 32, P0_I_E = 8 * 32;
constexpr int P0_NTR = P0_I_IN + P0_I_O + NE * 3 * P0_I_E, P0_NXG = T / 16;
DI TrItem p0_decode(const Frame& F, int it) {
    TrItem t; t.dst = nullptr; t.dst8 = nullptr; int r = it;
    if (r < NE * 3 * P0_I_E) {
        const int e = r / (3 * P0_I_E), which = (r / P0_I_E) % 3, rr = r % P0_I_E, kb = rr / 32, nb = rr % 32, c0 = nb * 32;
        if (which == 2) { t.src = F.in[I_WD] + (size_t)e * DFF * D + (size_t)(kb * 128) * D + c0; t.ldw = D; t.sc = -1; t.dst8 = WSP(unsigned char, WS_WD) + ((size_t)e * D + c0) * DFF + kb * 128; t.K = DFF; }
        else { const int drow = (c0 >> 7) * 256 + which * 128 + (c0 & 127);
            t.src = F.in[which ? I_WU : I_WG] + (size_t)e * D * DFF + (size_t)(kb * 128) * DFF + c0; t.ldw = DFF; t.sc = kb * 128; t.dst8 = WSP(unsigned char, WS_WGU) + ((size_t)e * 2048 + drow) * D + kb * 128; t.K = D; }
        return t; }
    r -= NE * 3 * P0_I_E;
    if (r < P0_I_IN) { const int kb = r / 96, nb = r % 96, j0 = nb * 32; const int col0 = j0 < 1536 ? j0 : (j0 < 2048 ? 1552 + (j0 - 1536) : 2064 + (j0 - 2048));
        t.src = F.in[I_WIN] + (size_t)(kb * 64) * D_IN + col0; t.ldw = D_IN; t.sc = 1024 + kb * 64; t.dst = WSP(bf16, WS_WIN) + (size_t)j0 * D + kb * 64; t.K = D; return t; }
    r -= P0_I_IN;
    { const int kb = r / 32, nb = r % 32; t.src = F.in[I_WOUT] + (size_t)(kb * 64) * D + nb * 32; t.ldw = D; t.sc = -1; t.dst = WSP(bf16, WS_WO) + (size_t)(nb * 32) * D + kb * 64; t.K = D; }
    return t;
}
DI void p0_prologue(const Frame& F) {
    LAS float* scr = (LAS float*)(F.lds + F.wave * P0_SCR_BYTES);
    LAS bf16* WX = (LAS bf16*)(F.lds + P0_WX_OFF);
    const float* x = F.in[I_X]; const float* nmix = F.in[I_NMIX]; const float* win = F.in[I_WIN];
    const int gw = F.bid * 8 + F.wave, NGW = F.G * 8;
    LAS float* SCL = (LAS float*)(F.lds + P0_SCL_OFF);
    for (int i = F.tid; i < 1024; i += 512) { SCL[i] = F.in[I_NFFN][i] * WSCALE; SCL[1024 + i] = nmix[i]; }
    __syncthreads();
    if (gw < P0_NTR) {
        TrItem cur = p0_decode(F, gw); f32x4 ra[16]; tr_load(cur, ra, F.lane);
        for (int it = gw; it < P0_NTR; it += NGW) {
            const bool more = it + NGW < P0_NTR; TrItem nxt = cur; f32x4 rb[16];
            if (more) { nxt = p0_decode(F, it + NGW); tr_load(nxt, rb, F.lane); }
            tr_store(cur, ra, scr, SCL, F.lane);
            if (more) {
#pragma unroll
                for (int i = 0; i < 16; ++i) ra[i] = rb[i];
                cur = nxt; }
        }
    }
    for (int idx = F.bid * 512 + F.tid; idx < 32 * 1024; idx += F.G * 512) { const int e = idx >> 10, k = idx & 1023; const float w = F.in[I_RW][(size_t)k * 32 + e] * F.in[I_NFFN][k];
        const unsigned hi = f2bf(w); bf16* wrt = WSP(bf16, WS_WRT); wrt[idx] = (bf16)hi; wrt[32 * 1024 + idx] = (bf16)f2bf(w - bf2f(hi)); }
    __syncthreads();
    {   f32x4 wv[2][6]; float sc[2];
#pragma unroll
        for (int rr = 0; rr < 2; ++rr) { const int k = F.tid + 512 * rr; const float* wr_ = win + (size_t)k * D_IN; sc[rr] = nmix[k];
#pragma unroll
            for (int i = 0; i < 4; ++i) wv[rr][i] = *(const f32x4*)(wr_ + 1536 + 4 * i);
            wv[rr][4] = *(const f32x4*)(wr_ + 3088); wv[rr][5] = *(const f32x4*)(wr_ + 3092); }
#pragma unroll
        for (int rr = 0; rr < 2; ++rr) { const int k = F.tid + 512 * rr;
#pragma unroll
            for (int i = 0; i < 6; ++i)
#pragma unroll
                for (int e = 0; e < 4; ++e) WX[(4 * i + e) * P0_WXS + k] = (bf16)f2bf(wv[rr][i][e] * sc[rr]);
#pragma unroll
            for (int j = 24; j < 32; ++j) WX[j * P0_WXS + k] = (bf16)0; }
    }
    __syncthreads();
    for (int g = NGW - 1 - gw; g < P0_NXG; g += NGW) {
        const int row0 = g * 16, r = F.lane & 15, q = F.lane >> 4;
        const float* xr = x + (size_t)(row0 + r) * D + 8 * q; bf16* xb = WSP(bf16, WS_XB) + (size_t)(row0 + r) * D + 8 * q;
        f32x4 a0 = {0.f, 0.f, 0.f, 0.f}, a1 = a0; float ss = 0.f;
        f32x4 xq[8][8];
#define P0_LOADX(gq) do { _Pragma("unroll") for (int kq = 0; kq < 4; ++kq) { xq[gq][2 * kq] = *(const f32x4*)(xr + 32 * (4 * (gq) + kq)); xq[gq][2 * kq + 1] = *(const f32x4*)(xr + 32 * (4 * (gq) + kq) + 4); } } while (0)
        P0_LOADX(0); P0_LOADX(1);
#pragma unroll
        for (int gq = 0; gq < 8; ++gq) {
            if (gq + 2 < 8) P0_LOADX(gq + 2);
#pragma unroll
            for (int kq = 0; kq < 4; ++kq) { const int kk = 4 * gq + kq;
                const f32x4 a = xq[gq][2 * kq], b = xq[gq][2 * kq + 1];
                ss += (a.x * a.x + a.y * a.y) + (a.z * a.z + a.w * a.w) + (b.x * b.x + b.y * b.y) + (b.z * b.z + b.w * b.w);
                const bf16x8 A = pack8(a, b);
                *(v4u*)(xb + 32 * kk) = __builtin_bit_cast(v4u, A);
                const bf16x8 B0 = *(const LAS bf16x8*)(WX + r * P0_WXS + 32 * kk + 8 * q), B1 = *(const LAS bf16x8*)(WX + (16 + r) * P0_WXS + 32 * kk + 8 * q);
                a0 = mfma16(A, B0, a0); a1 = mfma16(A, B1, a1);
                asm volatile("" ::: "memory"); }
        }
#undef P0_LOADX
        ss += __shfl_xor(ss, 16); ss += __shfl_xor(ss, 32);
        const float rstd = 1.0f / sqrtf(ss * (1.0f / D) + 1e-6f);
        if (q == 0) WSP(float, WS_RSTD1)[row0 + r] = rstd;
        float* ex = WSP(float, WS_EXTRA);
#pragma unroll
        for (int v = 0; v < 4; ++v) { const float rs = __shfl(rstd, 4 * q + v); ex[(size_t)(row0 + 4 * q + v) * 32 + r] = a0[v] * rs; ex[(size_t)(row0 + 4 * q + v) * 32 + 16 + r] = a1[v] * rs; }
    }
}

constexpr int TS = 68;
constexpr int NS = 132;
DI void ssd_tab_load(const Frame& F, int tok0, int g, float& dtraw, float& dtb, float& alog) {
    const int hd = 4 * g + (F.wave & 3);
    dtraw = WSP(float, WS_EXTRA)[(size_t)(tok0 + F.lane) * 32 + 16 + hd]; dtb = F.in[I_DTB][hd]; alog = F.in[I_ALOG][hd];
}
DI void ssd_tables(const Frame& F, int tok0, int g, LAS float* DTt, LAS float* ACt, LAS float* WGt, float* sdec_out  , float dtraw, float dtb, float alog) {
    if (F.wave < 4) { const int hl = F.wave;
        const float dtr = dtraw + dtb;
        const float dtv = softplus(dtr); const float a = -fexp(alog) * dtv; const float ac = wave_incl_scan(a, F.lane);
        const float ac63 = __shfl(ac, 63);
        DTt[hl * 64 + F.lane] = dtv; ACt[hl * 64 + F.lane] = ac; if (WGt) WGt[hl * 64 + F.lane] = fexp(ac63 - ac) * dtv;
        if (sdec_out && F.lane == 0) sdec_out[hl] = fexp(ac63); }
}
DI bf16x8 tr_frag(const LAS bf16* T_, int S, int ra, int rb, int col0, int lane) {
    const int rr = (lane & 15) >> 2, cc = col0 + 4 * (lane & 3);
    const s16x4 a = __builtin_amdgcn_ds_read_tr16_b64_v4i16((LAS s16x4*)(T_ + (ra + rr) * S + cc)), b = __builtin_amdgcn_ds_read_tr16_b64_v4i16((LAS s16x4*)(T_ + (rb + rr) * S + cc));
    return __builtin_shufflevector(a, b, 0, 1, 2, 3, 4, 5, 6, 7);
}
constexpr int RS = 528;
constexpr int QS = 72;
constexpr int VS = 144;
constexpr int XS = 272;
DI int ssd_srcc(int g, int cl) { return cl < 256 ? g * 256 + cl : (cl < 384 ? 512 + g * 128 + (cl - 256) : 768 + g * 128 + (cl - 384)); }
#define P2S_DECL(p) v4u p##0, p##1, p##2, p##3, p##4, p##5, p##6, p##7, p##8; f32x2 p##w0, p##w1, p##w2, p##w3, p##cb; float p##t0, p##t1, p##t2
#define P2S_ARGS(p) p##0, p##1, p##2, p##3, p##4, p##5, p##6, p##7, p##8, p##w0, p##w1, p##w2, p##w3, p##cb, p##t0, p##t1, p##t2
#define P2S_PARAMS(p, Q) Q v4u& p##0, Q v4u& p##1, Q v4u& p##2, Q v4u& p##3, Q v4u& p##4, Q v4u& p##5, Q v4u& p##6, Q v4u& p##7, Q v4u& p##8, Q f32x2& p##w0, Q f32x2& p##w1, Q f32x2& p##w2, Q f32x2& p##w3, Q f32x2& p##cb, Q float& p##t0, Q float& p##t1, Q float& p##t2
DI void p2_ssd_load(const Frame& F, int b, int c, int g, P2S_PARAMS(r, )) {
    const int tok0 = b * SEQ + c * CH; const bf16* PROJ = WSP(bf16, WS_PROJ);
    ssd_tab_load(F, tok0, g, rt0, rt1, rt2);
    const int cp = F.tid & 255, s0c = ssd_srcc(g, 2 * cp); const float* cw = F.in[I_CW]; const float* cbp = F.in[I_CB];
    rw0 = *(const f32x2*)(cw + s0c); rw1 = *(const f32x2*)(cw + 1024 + s0c); rw2 = *(const f32x2*)(cw + 2048 + s0c); rw3 = *(const f32x2*)(cw + 3072 + s0c); rcb = *(const f32x2*)(cbp + s0c);
#define P2S_LD(i, dst) { const int ch = F.tid + 512 * (i), row = ch >> 6, cc = ch & 63; const bool ok = (c > 0 || row >= 3); const int rr = (ch < 67 * 64) ? row : 66; \
        const v4u t_ = *(const v4u*)(PROJ + (size_t)(tok0 + (ok ? rr - 3 : 0)) * NPROJ + PC_XBC + ssd_srcc(g, 8 * cc)); dst = ok ? t_ : (v4u){0u, 0u, 0u, 0u}; }
    P2S_LD(0, r0) P2S_LD(1, r1) P2S_LD(2, r2) P2S_LD(3, r3) P2S_LD(4, r4) P2S_LD(5, r5) P2S_LD(6, r6) P2S_LD(7, r7) P2S_LD(8, r8)
#undef P2S_LD
}
template <bool PF> DI void p2_ssd_unit(const Frame& F, int b, int c, int g, P2S_PARAMS(v, const), int nu, P2S_PARAMS(n, )) {
    LAS bf16* RAW = (LAS bf16*)(F.lds);
    LAS bf16* OUT = (LAS bf16*)(F.lds + 67 * RS * 2);
    LAS float* DTt = (LAS float*)(F.lds + 131 * RS * 2);
    LAS float* ACt = DTt + 256; LAS float* WGt = ACt + 256;
    const int tok0 = b * SEQ + c * CH; const int l15 = F.lane & 15, q = F.lane >> 4;
    const bf16* PROJ = WSP(bf16, WS_PROJ); bf16* XBCA = WSP(bf16, WS_XBCA);
    const int cp = F.tid & 255, th = F.tid >> 8; const f32x2 w0 = vw0, w1 = vw1, w2 = vw2, w3 = vw3, cb = vcb;
    {   ssd_tables(F, tok0, g, DTt, ACt, WGt, WSP(float, WS_SDEC) + ((size_t)(b * NCH + c) * 8 + 4 * g), vt0, vt1, vt2);
#define P2S_ST(i, src) { const int ch = F.tid + 512 * (i), row = ch >> 6, cc = ch & 63; if (ch < 67 * 64) *(LAS v4u*)(RAW + row * RS + 8 * cc) = (src); }
        P2S_ST(0, v0) P2S_ST(1, v1) P2S_ST(2, v2) P2S_ST(3, v3) P2S_ST(4, v4) P2S_ST(5, v5) P2S_ST(6, v6) P2S_ST(7, v7) P2S_ST(8, v8)
#undef P2S_ST
    }
    if (PF) p2_ssd_load(F, nu >> 6, (nu & 63) >> 1, nu & 1, P2S_ARGS(n));
    __syncthreads();
    {
        const LAS unsigned* rp = (const LAS unsigned*)(RAW + (32 * th) * RS + 2 * cp); LAS unsigned* op = (LAS unsigned*)(OUT + (32 * th) * RS + 2 * cp);
        unsigned u = rp[0]; f32x2 xm3 = {bf2f(u & 0xffffu), bf2f(u >> 16)}; u = rp[RS / 2]; f32x2 xm2 = {bf2f(u & 0xffffu), bf2f(u >> 16)}; u = rp[RS]; f32x2 xm1 = {bf2f(u & 0xffffu), bf2f(u >> 16)};
#pragma unroll 8
        for (int t = 0; t < 32; ++t) { u = rp[(t + 3) * (RS / 2)]; const f32x2 xin = {bf2f(u & 0xffffu), bf2f(u >> 16)};
            f32x2 y = cb + w0 * xm3 + w1 * xm2 + w2 * xm1 + w3 * xin; xm3 = xm2; xm2 = xm1; xm1 = xin;
            op[t * (RS / 2)] = cvt_pk_bf16(silu(y.x), silu(y.y)); }
    }
    __syncthreads();
    {
#pragma unroll
        for (int i = 0; i < 8; ++i) { const int ch = F.tid + 512 * i, row = ch >> 6, cc = ch & 63; *(v4u*)(XBCA + (size_t)(tok0 + row) * 1024 + ssd_srcc(g, 8 * cc)) = *(const LAS v4u*)(OUT + row * RS + 8 * cc); }
    }
    {
        const int hl = F.wave >> 1, ph = F.wave & 1;
        f32x4 acc[8][2];
#pragma unroll
        for (int nn = 0; nn < 8; ++nn) { acc[nn][0] = (f32x4){0.f, 0.f, 0.f, 0.f}; acc[nn][1] = acc[nn][0]; }
#pragma unroll
        for (int kk = 0; kk < 2; ++kk) { bf16x8 Bop[2]; const int j0 = 32 * kk + 8 * q;
            const f32x4 w0 = *(const LAS f32x4*)(WGt + hl * 64 + j0), w1 = *(const LAS f32x4*)(WGt + hl * 64 + j0 + 4);
#pragma unroll
            for (int mp = 0; mp < 2; ++mp) { const bf16x8 raw = tr_frag(OUT, RS, j0, j0 + 4, hl * 64 + 32 * ph + 16 * mp, F.lane);
                f32x4 lo, hi;
#pragma unroll
                for (int j = 0; j < 4; ++j) { lo[j] = bf2f((unsigned short)raw[j]) * w0[j]; hi[j] = bf2f((unsigned short)raw[4 + j]) * w1[j]; }
                Bop[mp] = pack8(lo, hi); }
#pragma unroll
            for (int nn = 0; nn < 8; ++nn) { const bf16x8 Aop = tr_frag(OUT, RS, j0, j0 + 4, 256 + 16 * nn, F.lane);
                acc[nn][0] = mfma16(Aop, Bop[0], acc[nn][0]); acc[nn][1] = mfma16(Aop, Bop[1], acc[nn][1]); } }
        bf16* st = WSP(bf16, WS_LS) + ((size_t)(b * NCH + c) * 8 + 4 * g + hl) * 8192;
#pragma unroll
        for (int nn = 0; nn < 8; nn += 2)
#pragma unroll
            for (int mp = 0; mp < 2; ++mp) *(v4u*)(st + (32 * ph + 16 * mp + l15) * 128 + 16 * (nn + (q & 1)) + 4 * (q - (q & 1))) = widen16(pack4(acc[nn][mp]), pack4(acc[nn + 1][mp]));
    }
    __syncthreads();
}
#define P2G_DECL(p) v4u p##q, p##k, p##v0, p##v1; float p##a0, p##a1, p##u0, p##u1, p##ba
#define P2G_ARGS(p) p##q, p##k, p##v0, p##v1, p##a0, p##a1, p##u0, p##u1, p##ba
#define P2G_PARAMS(p, Q) Q v4u& p##q, Q v4u& p##k, Q v4u& p##v0, Q v4u& p##v1, Q float& p##a0, Q float& p##a1, Q float& p##u0, Q float& p##u1, Q float& p##ba
DI void p2_gla_load(const Frame& F, int b, int c, int h, P2G_PARAMS(r, )) {
    const int tok0 = b * SEQ + c * CH; const bf16* PROJ = WSP(bf16, WS_PROJ);
    { const int i = F.tid; ra0 = WSP(float, WS_EXTRA)[(size_t)(tok0 + (i >> 4)) * 32 + (i & 15)]; ru0 = F.in[I_WAUP][(size_t)(i >> 6) * 256 + h * 64 + (i & 63)]; }
    { const int i = F.tid + 512; ra1 = WSP(float, WS_EXTRA)[(size_t)(tok0 + (i >> 4)) * 32 + (i & 15)]; ru1 = F.in[I_WAUP][(size_t)(i >> 6) * 256 + h * 64 + (i & 63)]; }
    rba = F.in[I_BA][h * 64 + (F.tid & 63)];
    const int t = F.tid >> 3, seg = F.tid & 7; const bf16* src = PROJ + (size_t)(tok0 + t) * NPROJ + h * 64 + seg * 8;
    rq = *(const v4u*)(src + PC_Q); rk = *(const v4u*)(src + PC_K);
    const bf16* vs = PROJ + (size_t)(tok0 + t) * NPROJ + PC_V + h * 128 + seg * 16; rv0 = *(const v4u*)vs; rv1 = *(const v4u*)(vs + 8);
}
template <bool PF> DI void p2_gla_unit(const Frame& F, int b, int c, int h, P2G_PARAMS(v, const), int nu, P2G_PARAMS(n, )) {
    LAS bf16* QN = (LAS bf16*)(F.lds);
    LAS bf16* KN = (LAS bf16*)(F.lds + 64 * QS * 2);
    LAS bf16* VN = (LAS bf16*)(F.lds + 128 * QS * 2);
    LAS float* AL = (LAS float*)(F.lds + 128 * QS * 2 + 64 * VS * 2);
    LAS float* WU = AL + 1024;
    LAS float* TOT = WU + 1024;
    LAS float* DECL = TOT + 512;
    const int tok0 = b * SEQ + c * CH; const int l15 = F.lane & 15, q = F.lane >> 4;
    const bf16* PROJ = WSP(bf16, WS_PROJ);
    const float ba = vba;
    {   const int t = F.tid >> 3, seg = F.tid & 7;
        AL[F.tid] = va0; AL[F.tid + 512] = va1; WU[F.tid] = vu0; WU[F.tid + 512] = vu1;
        *(LAS v4u*)(QN + t * QS + seg * 8) = vq; *(LAS v4u*)(KN + t * QS + seg * 8) = vk; *(LAS v4u*)(VN + t * VS + seg * 16) = vv0; *(LAS v4u*)(VN + t * VS + seg * 16 + 8) = vv1; }
    if (PF) { const int v_ = nu - 512; p2_gla_load(F, v_ >> 7, (v_ & 127) >> 2, v_ & 3, P2G_ARGS(n)); }
    __syncthreads();
    const int d = F.tid & 63, tg = F.tid >> 6;
    float pc[8];
    {   float wu[16];
#pragma unroll
        for (int r = 0; r < 16; ++r) wu[r] = WU[r * 64 + d];
        float run = 0.f;
#pragma unroll
        for (int tt = 0; tt < 8; ++tt) { const int t = tg * 8 + tt; float z = ba;
#pragma unroll
            for (int r = 0; r < 16; ++r) z += AL[t * 16 + r] * wu[r];
            run += logsigmoid(z) * (1.0f / 16.0f); pc[tt] = run; }
        TOT[tg * 64 + d] = run; }
    __syncthreads();
    {   float pre = 0.f, tot = 0.f;
#pragma unroll
        for (int gI = 0; gI < 8; ++gI) { const float tv = TOT[gI * 64 + d]; tot += tv; if (gI < tg) pre += tv; }
        if (tg == 0) { const float dc = fexp(tot); DECL[d] = dc; WSP(float, WS_DECG)[((size_t)(b * NCH + c) * 4 + h) * 64 + d] = dc; }
#pragma unroll
        for (int tt = 0; tt < 8; ++tt) { const int t = tg * 8 + tt; const float bc = pc[tt] + pre; const float qv = bf2f(QN[t * QS + d]), kv = bf2f(KN[t * QS + d]);
            QN[t * QS + d] = (bf16)f2bf(qv * fexp(bc) * 0.125f); KN[t * QS + d] = (bf16)f2bf(kv * fexp(-bc)); }
    }
    __syncthreads();
    {   const int t = F.tid >> 3, seg = F.tid & 7; bf16* dst = WSP(bf16, WS_QKT) + (size_t)(tok0 + t) * 512 + h * 64 + seg * 8;
        *(v4u*)dst = *(const LAS v4u*)(QN + t * QS + seg * 8); *(v4u*)(dst + 256) = *(const LAS v4u*)(KN + t * QS + seg * 8); }
    {
        f32x4 acc[4];
#pragma unroll
        for (int md = 0; md < 4; ++md) acc[md] = (f32x4){0.f, 0.f, 0.f, 0.f};
#pragma unroll
        for (int kk = 0; kk < 2; ++kk) { const int j0 = 32 * kk + 8 * q; const bf16x8 Bop = tr_frag(VN, VS, j0, j0 + 4, 16 * F.wave, F.lane);
#pragma unroll
            for (int md = 0; md < 4; ++md) { const bf16x8 Aop = tr_frag(KN, QS, j0, j0 + 4, 16 * md, F.lane); acc[md] = mfma16(Aop, Bop, acc[md]); } }
        bf16* st = WSP(bf16, WS_LG) + ((size_t)(b * NCH + c) * 4 + h) * 8192 + (16 * F.wave + l15) * 64;
#pragma unroll
        for (int md = 0; md < 4; md += 2) { const f32x4 dc0 = *(const LAS f32x4*)(DECL + 16 * md + 4 * q), dc1 = *(const LAS f32x4*)(DECL + 16 * md + 16 + 4 * q);
            *(v4u*)(st + 16 * (md + (q & 1)) + 4 * (q - (q & 1))) = widen16(pack4(acc[md] * dc0), pack4(acc[md + 1] * dc1)); }
    }
    __syncthreads();
}

DI void p3_scan(const Frame& F) {
    constexpr int NG = 32 * 1024, NS_ = 64 * 1024;
    LAS float* DT = (LAS float*)(F.lds) + F.wave * 2048;
    for (int blk = F.wave * F.G + F.bid; blk * 64 < NG + NS_; blk += 8 * F.G) { const int it = blk * 64 + F.lane;
        f32x4 S0 = {0.f, 0.f, 0.f, 0.f}, S1 = S0;
        v4u lq[32];
        if (it < NG) { const int seq = it >> 10, e8 = it & 1023, b = seq >> 2, h = seq & 3, d0 = (e8 & 7) * 8;
            const size_t o = ((size_t)(b * NCH) * 4 + h) * 8192 + e8 * 8; const bf16* lp = WSP(bf16, WS_LG) + o; unsigned char* p = WSP(unsigned char, WS_STG) + o;
#pragma unroll
            for (int c = 0; c < NCH; ++c) lq[c] = *(const v4u*)(lp + (size_t)c * 4 * 8192);
            {   const float* dsrc = WSP(float, WS_DECG) + ((size_t)(b * NCH) * 4 + h) * 64;
                f32x4 dv[8];
#pragma unroll
                for (int k = 0; k < 8; ++k) { const int f4 = F.lane + 64 * k, c = f4 >> 4, dq = f4 & 15; dv[k] = *(const f32x4*)(dsrc + (size_t)c * 256 + 4 * dq); }
#pragma unroll
                for (int k = 0; k < 8; ++k) *(LAS f32x4*)(DT + 4 * (F.lane + 64 * k)) = dv[k]; }
#pragma unroll
            for (int c = 0; c < NCH; ++c) { v2u o8;
                o8.x = pk_fp8x4(sat8(S0.x * SGSCALE), sat8(S0.y * SGSCALE), sat8(S0.z * SGSCALE), sat8(S0.w * SGSCALE)); o8.y = pk_fp8x4(sat8(S1.x * SGSCALE), sat8(S1.y * SGSCALE), sat8(S1.z * SGSCALE), sat8(S1.w * SGSCALE));
                *(v2u*)(p + (size_t)c * 4 * 8192) = o8;
                const f32x4 dc0 = *(const LAS f32x4*)(DT + c * 64 + d0), dc1 = *(const LAS f32x4*)(DT + c * 64 + d0 + 4); const v4u l = lq[c];
                S0.x = S0.x * dc0.x + bf2f(l.x & 0xffffu); S0.y = S0.y * dc0.y + bf2f(l.x >> 16); S0.z = S0.z * dc0.z + bf2f(l.y & 0xffffu); S0.w = S0.w * dc0.w + bf2f(l.y >> 16);
                S1.x = S1.x * dc1.x + bf2f(l.z & 0xffffu); S1.y = S1.y * dc1.y + bf2f(l.z >> 16); S1.z = S1.z * dc1.z + bf2f(l.w & 0xffffu); S1.w = S1.w * dc1.w + bf2f(l.w >> 16); }
        } else { const int i2 = it - NG, seq = i2 >> 10, e8 = i2 & 1023, b = seq >> 3, hd = seq & 7;
            const size_t o = ((size_t)(b * NCH) * 8 + hd) * 8192 + e8 * 8; const bf16* lp = WSP(bf16, WS_LS) + o; unsigned char* p = WSP(unsigned char, WS_STS) + o;
#pragma unroll
            for (int c = 0; c < NCH; ++c) lq[c] = *(const v4u*)(lp + (size_t)c * 8 * 8192);
            const float dcl = WSP(float, WS_SDEC)[(size_t)(b * NCH + (F.lane & 31)) * 8 + hd];
#pragma unroll
            for (int c = 0; c < NCH; ++c) { v2u o8; const float dc = __int_as_float(__builtin_amdgcn_readlane(__float_as_int(dcl), c));
                o8.x = pk_fp8x4(sat8(S0.x * SSSCALE), sat8(S0.y * SSSCALE), sat8(S0.z * SSSCALE), sat8(S0.w * SSSCALE)); o8.y = pk_fp8x4(sat8(S1.x * SSSCALE), sat8(S1.y * SSSCALE), sat8(S1.z * SSSCALE), sat8(S1.w * SSSCALE));
                *(v2u*)(p + (size_t)c * 8 * 8192) = o8;
                const v4u l = lq[c];
                S0.x = S0.x * dc + bf2f(l.x & 0xffffu); S0.y = S0.y * dc + bf2f(l.x >> 16); S0.z = S0.z * dc + bf2f(l.y & 0xffffu); S0.w = S0.w * dc + bf2f(l.y >> 16);
                S1.x = S1.x * dc + bf2f(l.z & 0xffffu); S1.y = S1.y * dc + bf2f(l.z >> 16); S1.z = S1.z * dc + bf2f(l.w & 0xffffu); S1.w = S1.w * dc + bf2f(l.w >> 16); }
        }
    }
}

DI void p4_gla_load(const Frame& F, int b, int c, int h, v4u& qv, v4u& kv, v4u& v0, v4u& v1) {
    const int tok0 = b * SEQ + c * CH; const int t = F.tid >> 3, seg = F.tid & 7; const bf16* src = WSP(bf16, WS_QKT) + (size_t)(tok0 + t) * 512 + h * 64 + seg * 8;
    qv = *(const v4u*)(src); kv = *(const v4u*)(src + 256);
    const bf16* vs = WSP(bf16, WS_PROJ) + (size_t)(tok0 + t) * NPROJ + PC_V + h * 128 + seg * 16; v0 = *(const v4u*)vs; v1 = *(const v4u*)(vs + 8);
}
template <bool PF> DI void p4_gla_unit(const Frame& F, int b, int c, int h, const v4u& qv, const v4u& kv, const v4u& v0, const v4u& v1, int nu, v4u& nq, v4u& nk, v4u& nv0, v4u& nv1) {
    LAS bf16* QL = (LAS bf16*)(F.lds);
    LAS bf16* KL = (LAS bf16*)(F.lds + 64 * QS * 2);
    LAS bf16* VN = (LAS bf16*)(F.lds + 128 * QS * 2);
    LAS float* SSQ = (LAS float*)(F.lds + 128 * QS * 2 + 64 * VS * 2);
    const int tok0 = b * SEQ + c * CH; const int l15 = F.lane & 15, q = F.lane >> 4;
    const bf16* PROJ = WSP(bf16, WS_PROJ);
    {   const int t = F.tid >> 3, seg = F.tid & 7;
        *(LAS v4u*)(QL + t * QS + seg * 8) = qv; *(LAS v4u*)(KL + t * QS + seg * 8) = kv; *(LAS v4u*)(VN + t * VS + seg * 16) = v0; *(LAS v4u*)(VN + t * VS + seg * 16 + 8) = v1; }
    const int ri = F.wave & 3, vh = F.wave >> 2;
    const unsigned char* st = WSP(unsigned char, WS_STG) + ((size_t)(b * NCH + c) * 4 + h) * 8192;
    v4u sin_[4]; v2u gv_[4];
#pragma unroll
    for (int mv = 0; mv < 4; ++mv) sin_[mv] = *(const v4u*)(st + (64 * vh + 16 * mv + l15) * 64 + 16 * q);
    {   const bf16* gp_ = PROJ + (size_t)(tok0 + 16 * ri + l15) * NPROJ + PC_G + h * 128;
#pragma unroll
        for (int mv = 0; mv < 4; ++mv) gv_[mv] = *(const v2u*)(gp_ + 64 * vh + 16 * mv + 4 * q); }
    f32x4 nwv_[4];
#pragma unroll
    for (int mv = 0; mv < 4; ++mv) nwv_[mv] = *(const f32x4*)(F.in[I_GNW] + h * 128 + 64 * vh + 16 * mv + 4 * q);
    if (PF) { const int v = nu - 512; p4_gla_load(F, v >> 7, (v & 127) >> 2, v & 3, nq, nk, nv0, nv1); }
    __syncthreads();
    f32x4 sc[4];
#pragma unroll
    for (int mj = 0; mj < 4; ++mj) sc[mj] = (f32x4){0.f, 0.f, 0.f, 0.f};
#pragma unroll
    for (int mj = 0; mj < 4; ++mj) if (mj <= ri) {
#pragma unroll
        for (int kk = 0; kk < 2; ++kk) { const bf16x8 A = lds_frag(KL + (16 * mj + l15) * QS + 32 * kk + 8 * q), B = lds_frag(QL + (16 * ri + l15) * QS + 32 * kk + 8 * q); sc[mj] = mfma16(A, B, sc[mj]); }
        if (mj == ri) {
#pragma unroll
            for (int v = 0; v < 4; ++v) if (4 * q + v > l15) sc[mj][v] = 0.f; } }
    f32x4 acc[4];
#pragma unroll
    for (int mv = 0; mv < 4; ++mv) acc[mv] = (f32x4){0.f, 0.f, 0.f, 0.f};
#pragma unroll
    for (int kp = 0; kp < 2; ++kp) if (2 * kp <= ri) { const bf16x8 Bop = pack8(sc[2 * kp], sc[2 * kp + 1]);
#pragma unroll
        for (int mv = 0; mv < 4; ++mv) acc[mv] = mfma16(tr_frag(VN, VS, 32 * kp + 4 * q, 32 * kp + 16 + 4 * q, 64 * vh + 16 * mv, F.lane), Bop, acc[mv]); }
#pragma unroll
    for (int kk = 0; kk < 2; ++kk) { const bf16x8 Bq = lds_frag(QL + (16 * ri + l15) * QS + 16 * q + 8 * kk);
#pragma unroll
        for (int mv = 0; mv < 4; ++mv) acc[mv] = mfma16(fp8x8_to_bf16(sin_[mv][2 * kk], sin_[mv][2 * kk + 1], 1.0f / SGSCALE), Bq, acc[mv]); }
    float ss = 0.f;
#pragma unroll
    for (int mv = 0; mv < 4; ++mv) ss += (acc[mv].x * acc[mv].x + acc[mv].y * acc[mv].y) + (acc[mv].z * acc[mv].z + acc[mv].w * acc[mv].w);
    ss += __shfl_xor(ss, 16); ss += __shfl_xor(ss, 32);
    if (q == 0) SSQ[vh * 64 + 16 * ri + l15] = ss;
    __syncthreads();
    {   const int i = 16 * ri + l15; const float rs = 1.0f / sqrtf((SSQ[i] + SSQ[64 + i]) * (1.0f / 128.0f) + 1e-5f);
        bf16* op = WSP(bf16, WS_MIXED) + (size_t)(tok0 + i) * D + h * 128;
        v2u pw[4];
#pragma unroll
        for (int mv = 0; mv < 4; ++mv) { const v2u gv = gv_[mv]; const f32x4 w = nwv_[mv];
            f32x4 o; o.x = acc[mv].x * rs * w.x * silu(bf2f(gv.x & 0xffffu)); o.y = acc[mv].y * rs * w.y * silu(bf2f(gv.x >> 16));
            o.z = acc[mv].z * rs * w.z * silu(bf2f(gv.y & 0xffffu)); o.w = acc[mv].w * rs * w.w * silu(bf2f(gv.y >> 16));
            pw[mv] = pack4(o); }
#pragma unroll
        for (int mv = 0; mv < 4; mv += 2) *(v4u*)(op + 64 * vh + 16 * (mv + (q & 1)) + 4 * (q - (q & 1))) = widen16(pw[mv], pw[mv + 1]); }
    __syncthreads();
}
DI void p4_ssd_load(const Frame& F, int b, int c, int g, v4u& x0, v4u& x1, v4u& x2, v4u& x3, v4u& b0, v4u& b1, v4u& c0, v4u& c1, float& tdt, float& tb, float& ta) {
    const int tok0 = b * SEQ + c * CH; const bf16* XBCA = WSP(bf16, WS_XBCA);
    ssd_tab_load(F, tok0, g, tdt, tb, ta);
#define P4S_X(i) (*(const v4u*)(XBCA + (size_t)(tok0 + ((F.tid + 512 * (i)) >> 5)) * 1024 + g * 256 + 8 * ((F.tid + 512 * (i)) & 31)))
    x0 = P4S_X(0); x1 = P4S_X(1); x2 = P4S_X(2); x3 = P4S_X(3);
#undef P4S_X
    const int t = F.tid >> 3, seg = F.tid & 7; const bf16* bs = XBCA + (size_t)(tok0 + t) * 1024 + 512 + g * 128 + seg * 16;
    b0 = *(const v4u*)bs; b1 = *(const v4u*)(bs + 8); c0 = *(const v4u*)(bs + 256); c1 = *(const v4u*)(bs + 264);
}
template <bool PF> DI void p4_ssd_unit(const Frame& F, int b, int c, int g, const v4u& x0, const v4u& x1, const v4u& x2, const v4u& x3, const v4u& b0, const v4u& b1, const v4u& c0, const v4u& c1, float tb_dt, float tb_b, float tb_a,
                                       int nu, v4u& nx0, v4u& nx1, v4u& nx2, v4u& nx3, v4u& nb0, v4u& nb1, v4u& nc0, v4u& nc1, float& ntdt, float& ntb, float& nta) {
    LAS bf16* XN = (LAS bf16*)(F.lds);
    LAS bf16* BL = (LAS bf16*)(F.lds + 64 * XS * 2);
    LAS bf16* CL = (LAS bf16*)(F.lds + 64 * XS * 2 + 64 * VS * 2);
    LAS float* CB = (LAS float*)(F.lds + 64 * XS * 2 + 128 * VS * 2);
    LAS float* DTt = CB + 64 * TS;
    LAS float* ACt = DTt + 256; LAS float* SSQ = ACt + 256;
    const int tok0 = b * SEQ + c * CH; const int l15 = F.lane & 15, q = F.lane >> 4;
    const bf16* PROJ = WSP(bf16, WS_PROJ); const bf16* XBCA = WSP(bf16, WS_XBCA);
    const int hl = F.wave >> 1, ph = F.wave & 1, hd = 4 * g + hl;
    const unsigned char* st = WSP(unsigned char, WS_STS) + ((size_t)(b * NCH + c) * 8 + hd) * 8192;
    v4u sin_[2][2]; v2u zv_[4][2];
    {   const int t = F.tid >> 3, seg = F.tid & 7;
#pragma unroll
        for (int pr = 0; pr < 2; ++pr)
#pragma unroll
            for (int mp = 0; mp < 2; ++mp) sin_[pr][mp] = *(const v4u*)(st + (32 * ph + 16 * mp + l15) * 128 + 64 * pr + 16 * q);
#pragma unroll
        for (int ni = 0; ni < 4; ++ni)
#pragma unroll
            for (int mp = 0; mp < 2; ++mp) zv_[ni][mp] = *(const v2u*)(PROJ + (size_t)(tok0 + 16 * ni + l15) * NPROJ + PC_Z + g * 256 + hl * 64 + 32 * ph + 16 * mp + 4 * q);
        ssd_tables(F, tok0, g, DTt, ACt, nullptr, nullptr, tb_dt, tb_b, tb_a);
#define P4S_W(i, xv) { const int ch = F.tid + 512 * (i), tt = ch >> 5, cc = ch & 31; *(LAS v4u*)(XN + tt * XS + 8 * cc) = (xv); }
        P4S_W(0, x0) P4S_W(1, x1) P4S_W(2, x2) P4S_W(3, x3)
#undef P4S_W
        *(LAS v4u*)(BL + t * VS + seg * 16) = b0; *(LAS v4u*)(BL + t * VS + seg * 16 + 8) = b1; *(LAS v4u*)(CL + t * VS + seg * 16) = c0; *(LAS v4u*)(CL + t * VS + seg * 16 + 8) = c1;
    }
    const float* nw_ = F.in[I_SNW] + g * 256 + hl * 64 + 32 * ph; const f32x4 nw0_ = *(const f32x4*)(nw_ + 4 * q), nw1_ = *(const f32x4*)(nw_ + 16 + 4 * q); const float Dh = F.in[I_DSSD][hd];
    if (PF) p4_ssd_load(F, nu >> 6, (nu & 63) >> 1, nu & 1, nx0, nx1, nx2, nx3, nb0, nb1, nc0, nc1, ntdt, ntb, nta);
    __syncthreads();
    {
        const int mi = F.wave >> 1;
#pragma unroll
        for (int jj = 0; jj < 2; ++jj) { const int nj = 2 * (F.wave & 1) + jj; if (nj <= mi) { f32x4 a = {0.f, 0.f, 0.f, 0.f};
#pragma unroll
            for (int kk = 0; kk < 4; ++kk) a = mfma16(lds_frag(CL + (16 * mi + l15) * VS + 32 * kk + 8 * q), lds_frag(BL + (16 * nj + l15) * VS + 32 * kk + 8 * q), a);
#pragma unroll
            for (int v = 0; v < 4; ++v) CB[(16 * mi + 4 * q + v) * TS + 16 * nj + l15] = a[v]; } }
    }
    __syncthreads();
    f32x4 ya[2][4], yb[2][4];
#pragma unroll
    for (int mp = 0; mp < 2; ++mp)
#pragma unroll
        for (int ni = 0; ni < 4; ++ni) { ya[mp][ni] = (f32x4){0.f, 0.f, 0.f, 0.f}; yb[mp][ni] = ya[mp][ni]; }
    const LAS float* ach = ACt + hl * 64; const LAS float* dth = DTt + hl * 64;
#pragma unroll
    for (int kk = 0; kk < 2; ++kk) { bf16x8 Aop[2]; const int j0 = 32 * kk + 8 * q;
#pragma unroll
        for (int mp = 0; mp < 2; ++mp) Aop[mp] = tr_frag(XN, XS, j0, j0 + 4, hl * 64 + 32 * ph + 16 * mp, F.lane);
        const f32x4 aj0 = *(const LAS f32x4*)(ach + j0), aj1 = *(const LAS f32x4*)(ach + j0 + 4), dj0 = *(const LAS f32x4*)(dth + j0), dj1 = *(const LAS f32x4*)(dth + j0 + 4);
#pragma unroll
        for (int ni = 0; ni < 4; ++ni) if (32 * kk <= 16 * ni + 15) { const int i = 16 * ni + l15; const float ai = ach[i];
            const f32x4 c0 = *(const LAS f32x4*)(CB + i * TS + j0), c1 = *(const LAS f32x4*)(CB + i * TS + j0 + 4);
            f32x4 m0, m1;
#pragma unroll
            for (int j = 0; j < 4; ++j) { m0[j] = (j0 + j <= i) ? c0[j] * fexp(ai - aj0[j]) * dj0[j] : 0.f; m1[j] = (j0 + 4 + j <= i) ? c1[j] * fexp(ai - aj1[j]) * dj1[j] : 0.f; }
            const bf16x8 Bop = pack8(m0, m1);
            ya[0][ni] = mfma16(Aop[0], Bop, ya[0][ni]); ya[1][ni] = mfma16(Aop[1], Bop, ya[1][ni]); } }
#pragma unroll
    for (int kk = 0; kk < 4; ++kk) { bf16x8 As[2];
#pragma unroll
        for (int mp = 0; mp < 2; ++mp) As[mp] = fp8x8_to_bf16(sin_[kk >> 1][mp][2 * (kk & 1)], sin_[kk >> 1][mp][2 * (kk & 1) + 1], 1.0f / SSSCALE);
#pragma unroll
        for (int ni = 0; ni < 4; ++ni) { const bf16x8 Bc = lds_frag(CL + (16 * ni + l15) * VS + 64 * (kk >> 1) + 16 * q + 8 * (kk & 1)); yb[0][ni] = mfma16(As[0], Bc, yb[0][ni]); yb[1][ni] = mfma16(As[1], Bc, yb[1][ni]); } }
    float ssq[4];
#pragma unroll
    for (int ni = 0; ni < 4; ++ni) { const int i = 16 * ni + l15; const float ea = fexp(ach[i]); ssq[ni] = 0.f;
#pragma unroll
        for (int mp = 0; mp < 2; ++mp) { const int p0 = 16 * mp + 4 * q; const v2u zv = zv_[ni][mp]; const v2u xv = *(const LAS v2u*)(XN + i * XS + hl * 64 + 32 * ph + p0);
            const float zf[4] = {bf2f(zv.x & 0xffffu), bf2f(zv.x >> 16), bf2f(zv.y & 0xffffu), bf2f(zv.y >> 16)}; const float xf[4] = {bf2f(xv.x & 0xffffu), bf2f(xv.x >> 16), bf2f(xv.y & 0xffffu), bf2f(xv.y >> 16)};
#pragma unroll
            for (int v = 0; v < 4; ++v) { float y = ya[mp][ni][v] + ea * yb[mp][ni][v] + Dh * xf[v]; y *= silu(zf[v]); ya[mp][ni][v] = y; ssq[ni] += y * y; } } }
#pragma unroll
    for (int ni = 0; ni < 4; ++ni) { float s = ssq[ni]; s += __shfl_xor(s, 16); s += __shfl_xor(s, 32); if (q == 0) SSQ[F.wave * 64 + 16 * ni + l15] = s; }
    __syncthreads();
    {
#pragma unroll
        for (int ni = 0; ni < 4; ++ni) { const int i = 16 * ni + l15; float tot = 0.f;
#pragma unroll
            for (int w = 0; w < 8; ++w) tot += SSQ[w * 64 + i];
            const float rs = 1.0f / sqrtf(tot * (1.0f / 256.0f) + 1e-5f);
            bf16* op = WSP(bf16, WS_MIXED) + (size_t)(tok0 + i) * D + 512 + g * 256 + hl * 64 + 32 * ph;
            *(v4u*)(op + 16 * (q & 1) + 4 * (q - (q & 1))) = widen16(pack4(ya[0][ni] * rs * nw0_), pack4(ya[1][ni] * rs * nw1_)); } }
    __syncthreads();
}

constexpr int LGS = 33;
DI void p6_route(const Frame& F) {
    LAS float* WR = (LAS float*)(F.lds);
    LAS float* LGP = (LAS float*)(F.lds + RING_BYTES);
    LAS float* SSP = LGP + 64 * LGS;
    LAS int* LCNT = (LAS int*)(SSP + 128);
    LAS int* LBASE = LCNT + 32;
    const float* rw = F.in[I_RW]; const float* nffn = F.in[I_NFFN]; const float* rbias = F.in[I_RB];
    {   f32x4 wv[16]; float sc[16];
#pragma unroll
        for (int i = 0; i < 16; ++i) { const int idx = F.tid + 512 * i; wv[i] = *(const f32x4*)(rw + (size_t)idx * 4); sc[i] = nffn[idx >> 3]; }
#pragma unroll
        for (int i = 0; i < 16; ++i) { const int idx = F.tid + 512 * i; *(LAS f32x4*)(WR + idx * 4) = wv[i] * sc[i]; } }
    __syncthreads();
    const int l15 = F.lane & 15, q = F.lane >> 4, rg = F.wave & 3, kh = F.wave >> 2;
    const bf16* X1 = WSP(bf16, WS_X1); unsigned* gcnt = WSP(unsigned, WS_CTL) + CW_CNT;
    for (int rb = F.bid; rb < T / 64; rb += F.G) {
        const int row0 = rb * 64;
        if (F.tid < 32) LCNT[F.tid] = 0;
        const bf16* xr = X1 + (size_t)(row0 + 16 * rg + l15) * D + 512 * kh + 4 * q;
        f32x4 a0 = {0.f, 0.f, 0.f, 0.f}, a1 = a0; float ss = 0.f; f32x4 xa[32];
#pragma unroll
        for (int j = 0; j < 32; ++j) { const v2u t_ = *(const v2u*)(xr + 16 * j); xa[j] = (f32x4){bf2f(t_.x & 0xffffu), bf2f(t_.x >> 16), bf2f(t_.y & 0xffffu), bf2f(t_.y >> 16)}; }
#pragma unroll
        for (int j = 0; j < 32; ++j) { const f32x4 a = xa[j]; ss += (a.x * a.x + a.y * a.y) + (a.z * a.z + a.w * a.w);
#pragma unroll
            for (int e = 0; e < 4; ++e) { const int k = 512 * kh + 16 * j + 4 * q + e; const float b0 = WR[k * 32 + l15], b1 = WR[k * 32 + 16 + l15];
                a0 = __builtin_amdgcn_mfma_f32_16x16x4f32(a[e], b0, a0, 0, 0, 0); a1 = __builtin_amdgcn_mfma_f32_16x16x4f32(a[e], b1, a1, 0, 0, 0); } }
        ss += __shfl_xor(ss, 16); ss += __shfl_xor(ss, 32);
        if (q == 0) SSP[kh * 64 + 16 * rg + l15] = ss;
        if (kh == 1) {
#pragma unroll
            for (int v = 0; v < 4; ++v) { LGP[(16 * rg + 4 * q + v) * LGS + l15] = a0[v]; LGP[(16 * rg + 4 * q + v) * LGS + 16 + l15] = a1[v]; } }
        __syncthreads();
        if (kh == 0) {
#pragma unroll
            for (int v = 0; v < 4; ++v) { LGP[(16 * rg + 4 * q + v) * LGS + l15] += a0[v]; LGP[(16 * rg + 4 * q + v) * LGS + 16 + l15] += a1[v]; } }
        __syncthreads();
        int ek[4] = {0, 0, 0, 0}, rk[4] = {0, 0, 0, 0}; float gk[4] = {0.f, 0.f, 0.f, 0.f};
        if (F.tid < 64) { const int row = F.tid; const float rs = 1.0f / sqrtf((SSP[row] + SSP[64 + row]) * (1.0f / D) + 1e-6f);
            WSP(float, WS_RSTD2)[row0 + row] = rs;
            float v0 = -3.0e38f, v1 = -3.0e38f, v2 = -3.0e38f, v3 = -3.0e38f; int i0 = 0, i1 = 0, i2 = 0, i3 = 0;
#pragma unroll 4
            for (int e = 0; e < NE; ++e) { const float v = LGP[row * LGS + e] * rs + rbias[e];
                if (v > v0) { v3 = v2; i3 = i2; v2 = v1; i2 = i1; v1 = v0; i1 = i0; v0 = v; i0 = e; }
                else if (v > v1) { v3 = v2; i3 = i2; v2 = v1; i2 = i1; v1 = v; i1 = e; }
                else if (v > v2) { v3 = v2; i3 = i2; v2 = v; i2 = e; }
                else if (v > v3) { v3 = v; i3 = e; } }
            const float e1 = fexp(v1 - v0), e2 = fexp(v2 - v0), e3 = fexp(v3 - v0), inv = 1.0f / (1.0f + e1 + e2 + e3);
            ek[0] = i0; ek[1] = i1; ek[2] = i2; ek[3] = i3; gk[0] = inv; gk[1] = e1 * inv; gk[2] = e2 * inv; gk[3] = e3 * inv;
#pragma unroll
            for (int k = 0; k < 4; ++k) rk[k] = __hip_atomic_fetch_add(LCNT + ek[k], 1, __ATOMIC_RELAXED, __HIP_MEMORY_SCOPE_WORKGROUP); }
        __syncthreads();
        if (F.tid < 32) { const int cN = LCNT[F.tid]; LBASE[F.tid] = cN ? (int)__hip_atomic_fetch_add(gcnt + F.tid, (unsigned)cN, RLX_AGENT) : 0; }
        __syncthreads();
        if (F.tid < 64) { int* list = WSP(int, WS_LIST); float* gw = WSP(float, WS_GATEW); const int tok = row0 + F.tid;
#pragma unroll
            for (int k = 0; k < 4; ++k) { list[(size_t)ek[k] * LISTCAP + LBASE[ek[k]] + rk[k]] = tok * 4 + k; gw[tok * 4 + k] = gk[k]; } }
        __syncthreads();
    }
}
DI void p6_route_slim(const Frame& F) {
    LAS float* LGP = (LAS float*)(F.lds);
    LAS float* SSP = LGP + 64 * LGS;
    LAS int* LCNT = (LAS int*)(SSP + 64);
    LAS int* LBASE = LCNT + 32;
    const float* rbias = F.in[I_RB]; const float* PART = WSP(float, WS_PART); const float* PSS = WSP(float, WS_PSS); unsigned* gcnt = WSP(unsigned, WS_CTL) + CW_CNT;
    float rbv[NE];
#pragma unroll
    for (int e = 0; e < NE; ++e) rbv[e] = rbias[e];
    for (int rb = F.bid; rb < T / 64; rb += F.G) {
        const int row0 = rb * 64;
        if (F.tid < 32) LCNT[F.tid] = 0;
        {   const int row = F.tid >> 3, j = F.tid & 7; const float* p = PART + (size_t)(row0 + row) * 32 + 4 * j; const float* ps = PSS + row0 + (F.tid & 63);
            const f32x4 p0 = *(const f32x4*)p, p1 = *(const f32x4*)(p + (size_t)T * 32), p2 = *(const f32x4*)(p + (size_t)2 * T * 32), p3 = *(const f32x4*)(p + (size_t)3 * T * 32);
            const float q0 = ps[0], q1 = ps[T], q2 = ps[2 * T], q3 = ps[3 * T];
            asm volatile("" :: "v"(p0), "v"(p1), "v"(p2), "v"(p3), "v"(q0), "v"(q1), "v"(q2), "v"(q3));
            const f32x4 s = add4(add4(p0, p1), add4(p2, p3));
            LGP[row * LGS + 4 * j] = s.x; LGP[row * LGS + 4 * j + 1] = s.y; LGP[row * LGS + 4 * j + 2] = s.z; LGP[row * LGS + 4 * j + 3] = s.w;
            if (F.tid < 64) SSP[F.tid] = (q0 + q1) + (q2 + q3); }
        __syncthreads();
        int ek[4] = {0, 0, 0, 0}, rk[4] = {0, 0, 0, 0}; float gk[4] = {0.f, 0.f, 0.f, 0.f};
        if (F.tid < 64) { const int row = F.tid; const float rs = 1.0f / sqrtf(SSP[row] * (1.0f / D) + 1e-6f);
            WSP(float, WS_RSTD2)[row0 + row] = rs;
            float v0 = -3.0e38f, v1 = -3.0e38f, v2 = -3.0e38f, v3 = -3.0e38f; int i0 = 0, i1 = 0, i2 = 0, i3 = 0;
#pragma unroll
            for (int e = 0; e < NE; ++e) { const float v = LGP[row * LGS + e] * rs + rbv[e];
                if (v > v0) { v3 = v2; i3 = i2; v2 = v1; i2 = i1; v1 = v0; i1 = i0; v0 = v; i0 = e; }
                else if (v > v1) { v3 = v2; i3 = i2; v2 = v1; i2 = i1; v1 = v; i1 = e; }
                else if (v > v2) { v3 = v2; i3 = i2; v2 = v; i2 = e; }
                else if (v > v3) { v3 = v; i3 = e; } }
            const float e1 = fexp(v1 - v0), e2 = fexp(v2 - v0), e3 = fexp(v3 - v0), inv = 1.0f / (1.0f + e1 + e2 + e3);
            ek[0] = i0; ek[1] = i1; ek[2] = i2; ek[3] = i3; gk[0] = inv; gk[1] = e1 * inv; gk[2] = e2 * inv; gk[3] = e3 * inv;
#pragma unroll
            for (int k = 0; k < 4; ++k) rk[k] = __hip_atomic_fetch_add(LCNT + ek[k], 1, __ATOMIC_RELAXED, __HIP_MEMORY_SCOPE_WORKGROUP); }
        __syncthreads();
        if (F.tid < 32) { const int cN = LCNT[F.tid]; LBASE[F.tid] = cN ? (int)__hip_atomic_fetch_add(gcnt + F.tid, (unsigned)cN, RLX_AGENT) : 0; }
        __syncthreads();
        if (F.tid < 64) { int* list = WSP(int, WS_LIST); float* gw = WSP(float, WS_GATEW); const int tok = row0 + F.tid;
#pragma unroll
            for (int k = 0; k < 4; ++k) { list[(size_t)ek[k] * LISTCAP + LBASE[ek[k]] + rk[k]] = tok * 4 + k; gw[tok * 4 + k] = gk[k]; } }
        __syncthreads();
    }
}
DI void moe_tables(const Frame& F) {
    LAS int* PT = (LAS int*)(F.lds + MOE_OFF); LAS int* CNT = PT + 40;
    if (F.tid < 64) {
        const int cn = F.tid < NE ? (int)__hip_atomic_load(WSP(unsigned, WS_CTL) + CW_CNT + F.tid, RLX_AGENT) : 0; const int nt_ = (cn + 255) >> 8; int inc = nt_;
#pragma unroll
        for (int o = 1; o < 32; o <<= 1) { const int up = __shfl_up(inc, o); if ((F.tid & 63) >= o) inc += up; }
        if (F.tid < NE) { CNT[F.tid] = cn; PT[F.tid] = inc - nt_; if (F.tid == NE - 1) PT[NE] = inc; } }
    __syncthreads();
}
DI void p9_final(const Frame& F) {
    const int gw = F.bid * 8 + F.wave, NGW = F.G * 8; const float* fw = F.in[I_FNW];
    f32x4 fwv[4];
#pragma unroll
    for (int j = 0; j < 4; ++j) fwv[j] = *((const f32x4*)fw + F.lane + 64 * j);
    for (int row = gw; row < T; row += 2 * NGW) {
        const int row2 = row + NGW < T ? row + NGW : row;
        v2u xa[2][4]; int ya[2][4][4];
#pragma unroll
        for (int r = 0; r < 2; ++r) { const int rw = r ? row2 : row; const v2u* xr = (const v2u*)(WSP(bf16, WS_X1) + (size_t)rw * D) + F.lane; const int* yr = (const int*)(WSP(unsigned char, WS_Y4) + (size_t)rw * 4 * D) + F.lane;
#pragma unroll
            for (int j = 0; j < 4; ++j) { xa[r][j] = xr[64 * j];
#pragma unroll
                for (int k = 0; k < 4; ++k) ya[r][j][k] = yr[k * 256 + 64 * j]; } }
        asm volatile("" : "+v"(xa[0][0]), "+v"(xa[0][1]), "+v"(xa[0][2]), "+v"(xa[0][3]) : "v"(xa[1][3]), "v"(ya[1][3][3]), "v"(ya[1][0][0]), "v"(xa[1][0]));
#pragma unroll
        for (int r = 0; r < 2; ++r) { const int rw = r ? row2 : row; if (r && row2 == row) break;
            f32x4 v[4]; float ss = 0.f;
#pragma unroll
            for (int j = 0; j < 4; ++j) { const v2u t_ = xa[r][j]; v[j] = (f32x4){bf2f(t_.x & 0xffffu), bf2f(t_.x >> 16), bf2f(t_.y & 0xffffu), bf2f(t_.y >> 16)}; f32x2 lo = {0.f, 0.f}, hi = {0.f, 0.f};
#pragma unroll
                for (int k = 0; k < 4; ++k) { const int y = ya[r][j][k]; lo += __builtin_amdgcn_cvt_pk_f32_fp8(y, false); hi += __builtin_amdgcn_cvt_pk_f32_fp8(y, true); }
                v[j].x += lo.x * YSCALE_INV; v[j].y += lo.y * YSCALE_INV; v[j].z += hi.x * YSCALE_INV; v[j].w += hi.y * YSCALE_INV;
                ss += (v[j].x * v[j].x + v[j].y * v[j].y) + (v[j].z * v[j].z + v[j].w * v[j].w); }
#pragma unroll
            for (int o = 1; o < 64; o <<= 1) ss += __shfl_xor(ss, o);
            const float rs = 1.0f / sqrtf(ss * (1.0f / D) + 1e-6f);
            f32x4* op = (f32x4*)(F.out + (size_t)rw * D) + F.lane;
#pragma unroll
            for (int j = 0; j < 4; ++j) op[64 * j] = v[j] * rs * fwv[j]; }
    }
}

__global__ void __launch_bounds__(512, 2) fwd(Args args) {
    extern __shared__ __attribute__((aligned(16))) unsigned char lds[];
    Frame F;
    F.lds = (LAS unsigned char*)lds; F.tid = threadIdx.x; F.lane = F.tid & 63; F.wave = __builtin_amdgcn_readfirstlane(F.tid >> 6); F.G = gridDim.x; F.bid = blockIdx.x;
    F.in = args.in; F.out = args.out; F.ws = args.ws;
    volatile LAS unsigned* MISC = (volatile LAS unsigned*)(F.lds + MISC_OFF);
    if (F.tid < 64) MISC[F.tid] = 0u;
    __syncthreads();
    XcdBarrier bar; bar.bar = WSP(unsigned, WS_CTL) + CW_BAR; bar.x = 0; bar.st = nullptr;
    if (N_LAUNCHES == 1) bar = xcd_barrier_post(WSP(unsigned, WS_CTL) + CW_BAR, MISC + 8);
    const int lo = args.ph_lo, hi = args.ph_hi;
#ifndef PH_MASK
#define PH_MASK 0x3ff
#endif
#define IN(k) ((((PH_MASK) >> (k)) & 1) && lo <= (k) && (k) < hi)
#ifndef BARREP
#define BARREP 0
#endif
#define SEAM(k) do { if (IN(k) && IN((k) + 1)) { xcd_barrier(bar); if (BARREP) xcd_barrier(bar); } } while (0)

#ifndef REPMASK
#define REPMASK 0
#endif
#define REP(k) (((REPMASK) >> (k)) & 1)
#define PH0() do { p0_prologue(F); __syncthreads(); } while (0)
#define PH1() do { pg8::DenseOrder S; S.init(WSP(bf16, WS_XB), WSP(bf16, WS_WIN), T, NPROJ, D * 2, F.G, F.bid); \
        pg8::EpiProj E{WSP(bf16, WS_PROJ), WSP(float, WS_RSTD1)}; \
        pg8::gemm_phase<pg8::EpiProj, pg8::DenseOrder, true, false, false, false>(F.lds, D * 2, S, E); } while (0)
#ifndef UREP
#define UREP 0
#endif
#define PH2() do { int ul_[8]; int nu_ = 0; for (int u_ = F.bid; u_ < 1536 && nu_ < 8; u_ += F.G) { const int u = (F.bid & 1) ? F.bid + (1536 - F.G) - (u_ - F.bid) : u_; if (u >= 0 && u < 1536) ul_[nu_++] = u; } \
        if (F.G == 256 && nu_ == 6) { int us0, us1, ug0, ug1, ug2, ug3; if (F.bid & 1) { ug0 = ul_[0]; ug1 = ul_[1]; ug2 = ul_[2]; ug3 = ul_[3]; us0 = ul_[4]; us1 = ul_[5]; } else { us0 = ul_[0]; us1 = ul_[1]; ug0 = ul_[2]; ug1 = ul_[3]; ug2 = ul_[4]; ug3 = ul_[5]; } \
            if (F.bid & 1) { P2_GLA_RUN(); P2_SSD_RUN(); } else { P2_SSD_RUN(); P2_GLA_RUN(); } } \
        else { for (int i_ = 0; i_ < nu_; ++i_) { const int u = ul_[i_]; \
            if (u < 512) { P2S_DECL(a); p2_ssd_load(F, u >> 6, (u & 63) >> 1, u & 1, P2S_ARGS(a)); p2_ssd_unit<false>(F, u >> 6, (u & 63) >> 1, u & 1, P2S_ARGS(a), 0, P2S_ARGS(a)); } \
            else { const int v = u - 512; P2G_DECL(a); p2_gla_load(F, v >> 7, (v & 127) >> 2, v & 3, P2G_ARGS(a)); p2_gla_unit<false>(F, v >> 7, (v & 127) >> 2, v & 3, P2G_ARGS(a), 0, P2G_ARGS(a)); } } } } while (0)
#define P2_SSD_RUN() do { P2S_DECL(a); P2S_DECL(b); p2_ssd_load(F, us0 >> 6, (us0 & 63) >> 1, us0 & 1, P2S_ARGS(a)); \
        p2_ssd_unit<true>(F, us0 >> 6, (us0 & 63) >> 1, us0 & 1, P2S_ARGS(a), us1, P2S_ARGS(b)); \
        p2_ssd_unit<false>(F, us1 >> 6, (us1 & 63) >> 1, us1 & 1, P2S_ARGS(b), 0, P2S_ARGS(a)); } while (0)
#define P2_GU(u) ((u) - 512)
#define P2_GLA_RUN() do { P2G_DECL(a); P2G_DECL(b); p2_gla_load(F, P2_GU(ug0) >> 7, (P2_GU(ug0) & 127) >> 2, P2_GU(ug0) & 3, P2G_ARGS(a)); \
        p2_gla_unit<true>(F, P2_GU(ug0) >> 7, (P2_GU(ug0) & 127) >> 2, P2_GU(ug0) & 3, P2G_ARGS(a), ug1, P2G_ARGS(b)); \
        p2_gla_unit<true>(F, P2_GU(ug1) >> 7, (P2_GU(ug1) & 127) >> 2, P2_GU(ug1) & 3, P2G_ARGS(b), ug2, P2G_ARGS(a)); \
        p2_gla_unit<true>(F, P2_GU(ug2) >> 7, (P2_GU(ug2) & 127) >> 2, P2_GU(ug2) & 3, P2G_ARGS(a), ug3, P2G_ARGS(b)); \
        p2_gla_unit<false>(F, P2_GU(ug3) >> 7, (P2_GU(ug3) & 127) >> 2, P2_GU(ug3) & 3, P2G_ARGS(b), 0, P2G_ARGS(a)); } while (0)
#define PH4() do {   \
        int ul_[8]; int nu_ = 0; for (int u_ = F.bid; u_ < 1536 && nu_ < 8; u_ += F.G) { const int u = (F.bid & 1) ? F.bid + (1536 - F.G) - (u_ - F.bid) : u_; if (u >= 0 && u < 1536) ul_[nu_++] = u; } \
        if (F.G == 256 && nu_ == 6) { int us0, us1, ug0, ug1, ug2, ug3; if (F.bid & 1) { ug0 = ul_[0]; ug1 = ul_[1]; ug2 = ul_[2]; ug3 = ul_[3]; us0 = ul_[4]; us1 = ul_[5]; } else { us0 = ul_[0]; us1 = ul_[1]; ug0 = ul_[2]; ug1 = ul_[3]; ug2 = ul_[4]; ug3 = ul_[5]; } \
            v4u a0, a1, a2, a3, a4, a5, a6, a7, b0_, b1_, b2_, b3_, b4_, b5_, b6_, b7_; float at0, at1, at2, bt0, bt1, bt2; \
            if (F.bid & 1) { P4_GLA_RUN(); P4_SSD_RUN(); } else { P4_SSD_RUN(); P4_GLA_RUN(); } } \
        else { for (int i_ = 0; i_ < nu_; ++i_) { const int u = ul_[i_]; v4u a0, a1, a2, a3, a4, a5, a6, a7; float at0, at1, at2; \
            if (u < 512) { p4_ssd_load(F, u >> 6, (u & 63) >> 1, u & 1, a0, a1, a2, a3, a4, a5, a6, a7, at0, at1, at2); p4_ssd_unit<false>(F, u >> 6, (u & 63) >> 1, u & 1, a0, a1, a2, a3, a4, a5, a6, a7, at0, at1, at2, 0, a0, a1, a2, a3, a4, a5, a6, a7, at0, at1, at2); } \
            else { const int v = u - 512; p4_gla_load(F, v >> 7, (v & 127) >> 2, v & 3, a0, a1, a2, a3); p4_gla_unit<false>(F, v >> 7, (v & 127) >> 2, v & 3, a0, a1, a2, a3, 0, a0, a1, a2, a3); } } } } while (0)
#define P4_SSD_RUN() do { p4_ssd_load(F, us0 >> 6, (us0 & 63) >> 1, us0 & 1, a0, a1, a2, a3, a4, a5, a6, a7, at0, at1, at2); \
        p4_ssd_unit<true>(F, us0 >> 6, (us0 & 63) >> 1, us0 & 1, a0, a1, a2, a3, a4, a5, a6, a7, at0, at1, at2, us1, b0_, b1_, b2_, b3_, b4_, b5_, b6_, b7_, bt0, bt1, bt2); \
        p4_ssd_unit<false>(F, us1 >> 6, (us1 & 63) >> 1, us1 & 1, b0_, b1_, b2_, b3_, b4_, b5_, b6_, b7_, bt0, bt1, bt2, 0, a0, a1, a2, a3, a4, a5, a6, a7, at0, at1, at2); } while (0)
#define P4_GV(u) ((u) - 512)
#define P4_GLA_RUN() do { p4_gla_load(F, P4_GV(ug0) >> 7, (P4_GV(ug0) & 127) >> 2, P4_GV(ug0) & 3, a0, a1, a2, a3); \
        p4_gla_unit<true>(F, P4_GV(ug0) >> 7, (P4_GV(ug0) & 127) >> 2, P4_GV(ug0) & 3, a0, a1, a2, a3, ug1, b0_, b1_, b2_, b3_); \
        p4_gla_unit<true>(F, P4_GV(ug1) >> 7, (P4_GV(ug1) & 127) >> 2, P4_GV(ug1) & 3, b0_, b1_, b2_, b3_, ug2, a0, a1, a2, a3); \
        p4_gla_unit<true>(F, P4_GV(ug2) >> 7, (P4_GV(ug2) & 127) >> 2, P4_GV(ug2) & 3, a0, a1, a2, a3, ug3, b0_, b1_, b2_, b3_); \
        p4_gla_unit<false>(F, P4_GV(ug3) >> 7, (P4_GV(ug3) & 127) >> 2, P4_GV(ug3) & 3, b0_, b1_, b2_, b3_, 0, a0, a1, a2, a3); } while (0)
#define PH5() do { pg8::DenseOrder S; S.init(WSP(bf16, WS_MIXED), WSP(bf16, WS_WO), T, D, D * 2, F.G, F.bid); \
        if (F.G == 256) { pg8::EpiX1R E{F.in[I_X], WSP(bf16, WS_X1), WSP(unsigned char, WS_X1B), WSP(bf16, WS_WRT), WSP(float, WS_PART), WSP(float, WS_PSS)};     \
            pg8::gemm_phase<pg8::EpiX1R, pg8::DenseOrder, true, false, false, false>(F.lds, D * 2, S, E); } \
        else { pg8::EpiX1 E{F.in[I_X], WSP(bf16, WS_X1), WSP(unsigned char, WS_X1B)}; \
            pg8::gemm_phase<pg8::EpiX1, pg8::DenseOrder, true, false, false, false>(F.lds, D * 2, S, E); } } while (0)
#define PH7() do { moe_tables(F); \
        pg8::MoeOrder<8, true> S; S.A = (const char*)WSP(unsigned char, WS_X1B); S.Bt = (const char*)WSP(unsigned char, WS_WGU); S.list = WSP(int, WS_LIST); \
        S.PT = (const LAS int*)(F.lds + MOE_OFF); S.CNT = S.PT + 40; S.G = F.G; S.c = F.bid; S.tstep = (size_t)256 * D; S.estep = (size_t)2048 * D; S.astep = 0; \
        pg8::EpiAct E{WSP(unsigned char, WS_ACT), WSP(float, WS_RSTD2), F.in[I_BG], F.in[I_BU]}; \
        pg8::gemm_phase<pg8::EpiAct, pg8::MoeOrder<8, true>, true, true, true, true, false, KREP7>(F.lds, D, S, E); } while (0)
#define PH8() do {   \
        pg8::MoeOrder<4, false> S; S.A = (const char*)WSP(unsigned char, WS_ACT); S.Bt = (const char*)WSP(unsigned char, WS_WD); S.list = WSP(int, WS_LIST); \
        S.PT = (const LAS int*)(F.lds + MOE_OFF); S.CNT = S.PT + 40; S.G = F.G; S.c = F.bid; S.tstep = (size_t)256 * DFF; S.estep = (size_t)D * DFF; S.astep = (size_t)256 * DFF; \
        pg8::EpiDown E{WSP(unsigned char, WS_Y4), WSP(float, WS_GATEW), F.in[I_BD]}; \
        pg8::gemm_phase<pg8::EpiDown, pg8::MoeOrder<4, false>, true, true, true, true, true>(F.lds, DFF, S, E); } while (0)
    if (IN(0)) { PH0(); if (REP(0)) PH0(); }
    SEAM(0);
    if (IN(1)) { PH1(); if (REP(1)) PH1(); }
    SEAM(1);
    if (IN(2)) { PH2(); if (REP(2)) PH2(); }
    SEAM(2);
    if (IN(3)) { p3_scan(F); if (REP(3)) p3_scan(F); }
    SEAM(3);
    if (IN(4)) { PH4(); if (REP(4)) PH4(); }
    SEAM(4);
    if (IN(5)) { PH5(); if (REP(5)) PH5(); }
    SEAM(5);
    if (IN(6)) { if (F.G == 256) p6_route_slim(F); else p6_route(F); }
    SEAM(6);
    if (IN(7)) { PH7(); if (REP(7)) PH7(); }
    SEAM(7);
    if (IN(8)) { PH8(); if (REP(8)) PH8(); }
    SEAM(8);
    if (IN(9)) { p9_final(F); if (REP(9)) p9_final(F); }
#undef IN
#undef SEAM
}

extern "C" void kernel_launch(void* const* d_in, const int* in_sizes, int n_in, void* d_out, int out_size, void* d_ws, size_t ws_size, hipStream_t stream) {
    static int grid = 0;
    if (grid == 0) {
        if (n_in != 23 || in_sizes[0] != T * D || out_size != T * D || ws_size < WS_END) { fprintf(stderr, "kernel_launch: unexpected shapes (n_in %d, in0 %d, out %d, ws %zu); nothing launched\n", n_in, n_in > 0 ? in_sizes[0] : -1, out_size, ws_size); grid = -1; return; }
        int dev = 0, cus = 0, per_cu = 0;
        if (hipGetDevice(&dev) != hipSuccess || hipDeviceGetAttribute(&cus, hipDeviceAttributeMultiprocessorCount, dev) != hipSuccess) { grid = -1; return; }
        if (hipFuncSetAttribute((const void*)fwd, hipFuncAttributeMaxDynamicSharedMemorySize, LDS_BYTES) != hipSuccess) { fprintf(stderr, "kernel_launch: hipFuncSetAttribute failed\n"); grid = -1; return; }
        if (hipOccupancyMaxActiveBlocksPerMultiprocessor(&per_cu, (const void*)fwd, 512, LDS_BYTES) != hipSuccess || per_cu < 1) { fprintf(stderr, "kernel_launch: occupancy query says %d blocks per CU\n", per_cu); }
        (void)hipGetLastError();
        grid = cus;
    }
    if (grid < 0) return;
    (void)hipMemsetAsync((char*)d_ws + WS_CTL, 0, CTL_ZERO_BYTES, stream);
    Args a{};
    for (int i = 0; i < 23; ++i) a.in[i] = (const float*)d_in[i];
    a.out = (float*)d_out; a.ws = (unsigned char*)d_ws;
    if (N_LAUNCHES == 1) { a.ph_lo = 0; a.ph_hi = NPHASE; hipLaunchKernelGGL(fwd, dim3(grid), dim3(512), LDS_BYTES, stream, a); }
    else { for (int p = 0; p < NPHASE; ++p) { a.ph_lo = p; a.ph_hi = p + 1; hipLaunchKernelGGL(fwd, dim3(grid), dim3(512), LDS_BYTES, stream, a); } }
}
```

```cpp
#include <hip/hip_runtime.h>
#include <cstdio>
#include <cstdint>

#define GAS __attribute__((address_space(1)))
#define LAS __attribute__((address_space(3)))
typedef unsigned short bf16;
typedef unsigned v4u __attribute__((ext_vector_type(4)));
typedef unsigned v2u __attribute__((ext_vector_type(2)));
typedef float f32x4 __attribute__((ext_vector_type(4)));
typedef float f32x2 __attribute__((ext_vector_type(2)));
typedef short bf16x8 __attribute__((ext_vector_type(8)));
typedef short s16x4 __attribute__((ext_vector_type(4)));
typedef int v8i __attribute__((ext_vector_type(8)));
typedef int v4i __attribute__((ext_vector_type(4)));
constexpr float YSCALE = 16.0f, YSCALE_INV = 1.0f / 16.0f;
constexpr float MSCALE = 16.0f;
constexpr float SGSCALE = 2.0f, SSSCALE = 8.0f;
constexpr float WSCALE = 256.0f, WSCALE_INV = 1.0f / 256.0f;
typedef GAS unsigned gu32;
#define RLX_AGENT __ATOMIC_RELAXED, __HIP_MEMORY_SCOPE_AGENT
#define DI __device__ __forceinline__

#ifndef MK_N_LAUNCHES
#define MK_N_LAUNCHES 1
#endif
#ifndef KREP7
#define KREP7 1
#endif
#ifndef EPI_TWICE
#define EPI_TWICE 0
#endif
constexpr int NPHASE = 10;
constexpr int N_LAUNCHES = MK_N_LAUNCHES;

constexpr int NB = 8, SEQ = 2048, T = NB * SEQ, D = 1024, CH = 64, NCH = SEQ / CH;
constexpr int D_IN = 3096, NPROJ = 3072;
constexpr int NE = 32, DFF = 1024;
constexpr int LISTCAP = T * 4;
constexpr int PC_Q = 0, PC_K = 256, PC_V = 512, PC_G = 1024, PC_Z = 1536, PC_XBC = 2048;

constexpr size_t MiB = 1u << 20;
constexpr size_t WS_CTL = 0, CTL_ZERO_BYTES = 32768;
constexpr size_t WS_RSTD1 = 1 * MiB, WS_RSTD2 = WS_RSTD1 + 65536, WS_GATEW = WS_RSTD2 + 65536  , WS_DECG = WS_GATEW + 262144  , WS_SDEC = WS_DECG + 262144  ;
constexpr size_t WS_WRT = 1 * MiB + 768 * 1024;
constexpr size_t WS_PART = 132 * MiB, WS_PSS = 140 * MiB;
constexpr size_t WS_EXTRA = 2 * MiB;
constexpr size_t WS_WIN = 4 * MiB, WS_WO = 10 * MiB, WS_LIST = 12 * MiB;
constexpr size_t WS_WGU = 20 * MiB  , WS_WD = 148 * MiB  ;
constexpr size_t WS_LG = 84 * MiB, WS_LS = 100 * MiB;
constexpr size_t WS_X1 = 212 * MiB, WS_X1B = 276 * MiB;
constexpr size_t WS_STG = 212 * MiB, WS_STS = 228 * MiB, WS_XBCA = 260 * MiB, WS_QKT = 292 * MiB  ;
constexpr size_t WS_XB = 308 * MiB, WS_PROJ = 340 * MiB, WS_MIXED = 436 * MiB;
constexpr size_t WS_ACT = 308 * MiB;
constexpr size_t WS_Y4 = 20 * MiB;
constexpr size_t WS_END = 512 * MiB;
constexpr int CW_TMO = 0, CW_CODE = 1, CW_CNT = 64, CW_BAR = 4096;

constexpr int RING_BYTES = 131072;
constexpr int TBL_OFF = 131072;
constexpr int MOE_OFF = TBL_OFF + 2048;
constexpr int EPI_OFF = MOE_OFF + 1024;
constexpr int LDS_BYTES = 147456;
constexpr int MISC_OFF = LDS_BYTES - 256;

DI float bf2f(unsigned v) { return __uint_as_float(v << 16); }
DI unsigned f2bf(float f) { unsigned u = __builtin_bit_cast(unsigned, f); return (u + 0x7fffu + ((u >> 16) & 1u)) >> 16; }
typedef __bf16 bf16x2_t __attribute__((ext_vector_type(2)));
DI unsigned cvt_pk_bf16(float lo, float hi) { const f32x2 v = {lo, hi}; return __builtin_bit_cast(unsigned, __builtin_convertvector(v, bf16x2_t)); }
DI float fexp(float x) { return __builtin_amdgcn_exp2f(x * 1.4426950408889634f); }
DI float flog(float x) { return __builtin_amdgcn_logf(x) * 0.6931471805599453f; }
DI float frcp(float x) { return __builtin_amdgcn_rcpf(x); }
DI float silu(float x) { return x * frcp(1.0f + fexp(-x)); }
DI float softplus(float x) { return fmaxf(x, 0.f) + flog(1.0f + fexp(-fabsf(x))); }
DI float logsigmoid(float x) { return fminf(x, 0.f) - flog(1.0f + fexp(-fabsf(x))); }
DI f32x4 mfma16(bf16x8 a, bf16x8 b, f32x4 c) { return __builtin_amdgcn_mfma_f32_16x16x32_bf16(a, b, c, 0, 0, 0); }
DI bf16x8 lds_frag(const LAS bf16* p) {
    const s16x4 a = *(const LAS s16x4*)p, b = *(const LAS s16x4*)(p + 4);
    return __builtin_shufflevector(a, b, 0, 1, 2, 3, 4, 5, 6, 7);
}
DI bf16x8 lds_frag2(const LAS bf16* p0, const LAS bf16* p1) {
    const s16x4 a = *(const LAS s16x4*)p0, b = *(const LAS s16x4*)p1;
    return __builtin_shufflevector(a, b, 0, 1, 2, 3, 4, 5, 6, 7);
}
DI f32x4 mul4(f32x4 a, float s) { const f32x2 s2 = {s, s}; const f32x2 lo = (f32x2){a.x, a.y} * s2, hi = (f32x2){a.z, a.w} * s2; return (f32x4){lo.x, lo.y, hi.x, hi.y}; }
DI f32x4 fma4(f32x4 a, float s, f32x4 b) { const f32x2 s2 = {s, s}; const f32x2 lo = (f32x2){a.x, a.y} * s2 + (f32x2){b.x, b.y}, hi = (f32x2){a.z, a.w} * s2 + (f32x2){b.z, b.w}; return (f32x4){lo.x, lo.y, hi.x, hi.y}; }
DI f32x4 add4(f32x4 a, f32x4 b) { const f32x2 lo = (f32x2){a.x, a.y} + (f32x2){b.x, b.y}, hi = (f32x2){a.z, a.w} + (f32x2){b.z, b.w}; return (f32x4){lo.x, lo.y, hi.x, hi.y}; }
DI v2u widen8(unsigned a, unsigned b) { const auto r = __builtin_amdgcn_permlane16_swap(a, b, false, false); return (v2u){r[0], r[1]}; }
DI v4u widen16(v2u a, v2u b) { const auto rx = __builtin_amdgcn_permlane16_swap(a.x, b.x, false, false); const auto ry = __builtin_amdgcn_permlane16_swap(a.y, b.y, false, false); return (v4u){rx[0], ry[0], rx[1], ry[1]}; }
DI bf16x8 pack8(f32x4 a, f32x4 b) { v4u p; p.x = cvt_pk_bf16(a.x, a.y); p.y = cvt_pk_bf16(a.z, a.w); p.z = cvt_pk_bf16(b.x, b.y); p.w = cvt_pk_bf16(b.z, b.w); return __builtin_bit_cast(bf16x8, p); }
DI v2u pack4(f32x4 a) { v2u p; p.x = cvt_pk_bf16(a.x, a.y); p.y = cvt_pk_bf16(a.z, a.w); return p; }
DI bf16x8 fp8x8_to_bf16(unsigned w0, unsigned w1, float s) {
    const f32x2 s2 = {s, s}; const f32x2 a = __builtin_amdgcn_cvt_pk_f32_fp8((int)w0, false) * s2, b = __builtin_amdgcn_cvt_pk_f32_fp8((int)w0, true) * s2, c = __builtin_amdgcn_cvt_pk_f32_fp8((int)w1, false) * s2, d = __builtin_amdgcn_cvt_pk_f32_fp8((int)w1, true) * s2;
    v4u p; p.x = cvt_pk_bf16(a.x, a.y); p.y = cvt_pk_bf16(b.x, b.y); p.z = cvt_pk_bf16(c.x, c.y); p.w = cvt_pk_bf16(d.x, d.y); return __builtin_bit_cast(bf16x8, p); }
DI float sat8(float v) { return __builtin_amdgcn_fmed3f(v, -448.0f, 448.0f); }
DI unsigned pk_fp8x4(float a, float b, float c, float d) { int w = 0; w = __builtin_amdgcn_cvt_pk_fp8_f32(a, b, w, false); w = __builtin_amdgcn_cvt_pk_fp8_f32(c, d, w, true); return (unsigned)w; }
DI unsigned pk_fp8s(f32x4 v, float sc) { return pk_fp8x4(sat8(v.x * sc), sat8(v.y * sc), sat8(v.z * sc), sat8(v.w * sc)); }
DI float wave_incl_scan(float v, int lane) {
#pragma unroll
    for (int o = 1; o < 64; o <<= 1) { const float u = __shfl_up(v, o); if (lane >= o) v += u; }
    return v;
}

namespace pg8 {
constexpr int BM = 256, BK = 64, HALF = 128, HTB = HALF * BK * 2, NXCD = 8, WGM = 8;
DI int lds_byte(int r, int c) { const int st = (r >> 4) * 2 + (c >> 5), rr = r & 15, cc = c & 31, ob = rr * 64 + cc * 2; return st * 1024 + (ob ^ (((ob >> 9) & 1) << 5)); }
DI void stage_rc(int b, int& R, int& C) { const int st = b / 1024, sb = b % 1024, swz = sb ^ (((sb >> 9) & 1) << 5); R = (st >> 1) * 16 + swz / 64; C = (st & 1) * 32 + (swz % 64) / 2; }
DI int perm32(int rho) { const int n = rho >> 4, i = rho & 15; return 8 * (i >> 2) + 4 * n + (i & 3); }

struct Unit { int pm, pn, e, valid, rt; };

struct DenseOrder {
    const char* A; const char* Bt; int nM, nN, nwg, G, c; size_t tstep; const int* lp = nullptr;
    DI void init(const void* A_, const void* Bt_, int M, int N, int KB, int G_, int c_) { A = (const char*)A_; Bt = (const char*)Bt_; nM = M / BM; nN = N / BM; nwg = nM * nN; G = G_; c = c_; tstep = (size_t)BM * KB; }
    DI bool next(int i, Unit& u) const {
        const long L = (long)i * G + c; if (L >= nwg) return false;
        int wgid = (int)L; { const int q = nwg / NXCD, r = nwg % NXCD, xcd = wgid % NXCD, off = wgid / NXCD; wgid = (xcd < r ? xcd * (q + 1) : r * (q + 1) + (xcd - r) * q) + off; }
        const int nig = WGM * nN, gid = wgid / nig, fm = gid * WGM, gsz = (nM - fm) < WGM ? (nM - fm) : WGM;
        u.pm = fm + ((wgid % nig) % gsz); u.pn = (wgid % nig) / gsz; u.e = 0; u.valid = 256; u.rt = 0; return true;
    }
    DI const char* a_base(const Unit& u) const { return A + (size_t)u.pm * tstep; }
    DI const char* b_base(const Unit& u) const { return Bt + (size_t)u.pn * tstep; }
    DI const int* list_ptr(const Unit&) const { return lp; }
};
template <int NCT, bool GATHER_A> struct MoeOrder {
    const char* A; const char* Bt; const int* list; const LAS int* PT; const LAS int* CNT; int G, c; size_t tstep, estep, astep;
    DI bool next(int i, Unit& u) const {
        const int Tt = __builtin_amdgcn_readfirstlane(PT[NE]); int tix, L;
        if ((G & 7) == 0) { const int ntx = (Tt + 7) >> 3, x = c & 7, j = i * (G >> 3) + (c >> 3), tl = j / NCT; tix = x * ntx + tl; L = j; if (tl >= ntx || tix >= Tt) return false; }
        else { L = i * G + c; tix = L / NCT; if (tix >= Tt) return false; }
        const int ln_ = (int)(threadIdx.x & 63);
        const int e = __builtin_popcountll(__ballot(ln_ < NE - 1 && PT[(ln_ < NE - 1) ? ln_ + 1 : 0] <= tix));
        u.pm = tix; u.pn = L % NCT; u.e = e; u.rt = tix - __builtin_amdgcn_readfirstlane(PT[e]); const int rem = __builtin_amdgcn_readfirstlane(CNT[e]) - u.rt * 256; u.valid = rem < 256 ? rem : 256; return true;
    }
    DI const char* a_base(const Unit& u) const { return GATHER_A ? A : A + (size_t)u.pm * astep; }
    DI const char* b_base(const Unit& u) const { return Bt + (size_t)u.e * estep + (size_t)u.pn * tstep; }
    DI const int* list_ptr(const Unit& u) const { return list + (size_t)u.e * LISTCAP + u.rt * 256; }
};

template <class Epi, class Sched, bool ALIGN_EPI, bool TABLE, bool GATHER, bool FP8, bool IDENT = false, int KREP = 1>
DI void gemm_phase(LAS unsigned char* lds, const int KB, const Sched& S, const Epi& E) {
    const int tid = threadIdx.x, wid = __builtin_amdgcn_readfirstlane(tid >> 6), lane = tid & 63, wr = wid >> 2, wc = wid & 3, fr = lane & 15, fq = lane >> 4;
    int nt = KB / 128; asm volatile("" : "+s"(nt));
    unsigned voffA[2], voffB[2]; int RA[2]; unsigned CA2[2];
#pragma unroll
    for (int i = 0; i < 2; ++i) { int R, C; stage_rc(tid * 16 + i * 8192, R, C); const int Rb = Epi::PERM ? ((R & ~31) + perm32(R & 31)) : R;
        voffA[i] = (unsigned)(R * KB + C * 2); voffB[i] = (unsigned)(Rb * KB + C * 2); RA[i] = R; CA2[i] = (unsigned)C * 2u; }
    const size_t kstep = (size_t)(BK * 2);
    const size_t hstep = (size_t)HALF * KB;
    const unsigned ldsw = (unsigned)wid * 1024u;
    const int aoff = lds_byte(wr * 64 + fr, fq * 8), boff = lds_byte(wc * 32 + fr, fq * 8);
    unsigned vA[2][2];
#define PG8_SA(b, h) (((b) * 2 + (h)) * HTB)
#define PG8_SB(b, h) ((4 + (b) * 2 + (h)) * HTB)
#define PG8_STAGE(bufoff, gbase, voff) do { _Pragma("unroll") for (int _i = 0; _i < 2; ++_i) \
        __builtin_amdgcn_global_load_lds((const unsigned*)((const char*)(gbase) + (voff)[_i]), (LAS unsigned*)(lds + (bufoff) + ldsw + _i * 8192), 16, 0, 0); } while (0)
#define PG8_STAGE_A(bufoff, gp, h, nx) PG8_STAGE(bufoff, gp, vA[h])
#define PG8_LDA(dst, b, h) do { _Pragma("unroll") for (int m = 0; m < 4; ++m) { \
        if constexpr (FP8) dst##8[m] = PG8_CAT(*(const LAS v4i*)(lds + PG8_SA(b, h) + aoff + m * 2048), *(const LAS v4i*)(lds + PG8_SA(b, h) + aoff + m * 2048 + 1024)); \
        else { _Pragma("unroll") for (int k = 0; k < 2; ++k) dst[m][k] = *(const LAS bf16x8*)(lds + PG8_SA(b, h) + aoff + m * 2048 + k * 1024); } } } while (0)
#define PG8_LDB(dst, b, h) do { _Pragma("unroll") for (int n = 0; n < 2; ++n) { \
        if constexpr (FP8) dst##8[n] = PG8_CAT(*(const LAS v4i*)(lds + PG8_SB(b, h) + boff + n * 2048), *(const LAS v4i*)(lds + PG8_SB(b, h) + boff + n * 2048 + 1024)); \
        else { _Pragma("unroll") for (int k = 0; k < 2; ++k) dst[n][k] = *(const LAS bf16x8*)(lds + PG8_SB(b, h) + boff + n * 2048 + k * 1024); } } } while (0)
#define PG8_CAT(x0, x1) __builtin_shufflevector(x0, x1, 0, 1, 2, 3, 4, 5, 6, 7)
#define PG8_MMA(ai, bj, At, Bt) do { __builtin_amdgcn_s_setprio(1); _Pragma("unroll") for (int m = 0; m < 4; ++m) _Pragma("unroll") for (int n = 0; n < 2; ++n) { \
        if constexpr (FP8) acc[ai][bj][m][n] = __builtin_amdgcn_mfma_scale_f32_16x16x128_f8f6f4(Bt##8[n], At##8[m], acc[ai][bj][m][n], 0, 0, 0, 0x7f7f7f7f, 0, 0x7f7f7f7f); \
        else { _Pragma("unroll") for (int k = 0; k < 2; ++k) acc[ai][bj][m][n] = __builtin_amdgcn_mfma_f32_16x16x32_bf16(Bt[n][k], At[m][k], acc[ai][bj][m][n], 0, 0, 0); } } \
        __builtin_amdgcn_s_setprio(0); } while (0)
#define PG8_WAIT_V(n) asm volatile("s_waitcnt vmcnt(" #n ")" ::: "memory")
#define PG8_WAIT_L(n) asm volatile("s_waitcnt lgkmcnt(" #n ")" ::: "memory")
#define PG8_BAR __builtin_amdgcn_s_barrier()
#define PG8_SCHED __builtin_amdgcn_sched_barrier(0)
#define PG8_ROWS1(h, par, vld) do { const LAS int* _tb = (const LAS int*)(lds + TBL_OFF + (par) * 1024); _Pragma("unroll") for (int _i = 0; _i < 2; ++_i) { \
        const int _r = (h) * HALF + RA[_i]; const int _s = _tb[_r]; unsigned _tok = (_r < (vld)) ? ((unsigned)_s >> 2) : 0u; if constexpr (IDENT) _tok = (unsigned)_r + ((unsigned)_s & 0u); vA[h][_i] = _tok * (unsigned)KB + CA2[_i]; } } while (0)
#define PG8_TBL_DMA(lp, par) do { if (wid == 0) { int ln_ = (int)threadIdx.x; asm volatile("" : "+v"(ln_)); __builtin_amdgcn_global_load_lds((const unsigned*)((const int*)(lp) + ln_ * 4), (LAS unsigned*)(lds + TBL_OFF + (par) * 1024), 16, 0, 0); } } while (0)
    if constexpr (!GATHER) {
#pragma unroll
        for (int i = 0; i < 2; ++i) { vA[0][i] = voffA[i]; vA[1][i] = voffA[i] + (unsigned)hstep; } }
    Unit cur, nxt; int ui = 0;
    if (!S.next(0, cur)) return;
    f32x4 acc[2][2][4][2];
#pragma unroll
    for (int a = 0; a < 2; ++a)
#pragma unroll
        for (int b = 0; b < 2; ++b)
#pragma unroll
            for (int m = 0; m < 4; ++m)
#pragma unroll
                for (int n = 0; n < 2; ++n) acc[a][b][m][n] = (f32x4){0.f, 0.f, 0.f, 0.f};
    bf16x8 At[4][2], B0[2][2], B1[2][2]; v8i At8[4], B08[2], B18[2];
    const char* cA = S.a_base(cur); const char* cB = S.b_base(cur);
    if constexpr (TABLE) {
        PG8_TBL_DMA(S.list_ptr(cur), 0); PG8_STAGE(PG8_SB(0, 0), cB, voffB); PG8_STAGE(PG8_SB(0, 1), cB + hstep, voffB);
        PG8_WAIT_V(4); PG8_BAR; asm volatile("" ::: "memory");
        if constexpr (GATHER) { PG8_ROWS1(0, 0, cur.valid); PG8_ROWS1(1, 0, cur.valid); }
    }
    if constexpr (!TABLE) { PG8_STAGE(PG8_SB(0, 0), cB, voffB); PG8_STAGE(PG8_SB(0, 1), cB + hstep, voffB); }
    PG8_STAGE_A(PG8_SA(0, 0), cA, 0, false); PG8_STAGE_A(PG8_SA(0, 1), cA, 1, false);
    if (wr == 1) PG8_BAR;
    PG8_WAIT_V(2); PG8_BAR;
    PG8_STAGE(PG8_SB(1, 0), cB + kstep, voffB); PG8_STAGE_A(PG8_SA(1, 0), cA + kstep, 0, false); PG8_STAGE(PG8_SB(1, 1), cB + hstep + kstep, voffB);
    PG8_WAIT_V(6); PG8_BAR;
    for (;;) {
        const bool has_next = S.next(ui + 1, nxt);
        const char* nA = has_next ? S.a_base(nxt) : cA; const char* nB = has_next ? S.b_base(nxt) : cB;
        const int nvalid = has_next ? nxt.valid : cur.valid;
#pragma unroll 1
        for (int t0_ = 0; t0_ < nt * KREP; t0_ += 2) {
            const int t = (KREP == 1) ? t0_ : (t0_ % nt);
            const bool last = (t0_ == nt * KREP - 2);
            asm volatile("" : "+v"(vA[0][0]), "+v"(vA[0][1]), "+v"(vA[1][0]), "+v"(vA[1][1]), "+v"(voffB[0]), "+v"(voffB[1]));
            if constexpr (TABLE) { if (t0_ == nt * KREP - 4 && has_next) PG8_TBL_DMA(S.list_ptr(nxt), (ui + 1) & 1); }
            if constexpr (Epi::PREFETCH) { if (t0_ == 0) { const float* gp_ = E.pf_addr(cur, (const LAS int*)(lds + TBL_OFF + (ui & 1) * 1024));
                    if (wid < Epi::PF_WAVES) __builtin_amdgcn_global_load_lds((const unsigned*)gp_, (LAS unsigned*)(lds + EPI_OFF + (ui & 1) * 2048 + wid * 256), 4, 0, 0); } }
            const char* a1 = cA + (size_t)(t + 1) * kstep;
            const int t2_ = (KREP == 1) ? t + 2 : ((t + 2) % nt);
            const char* a2 = last ? nA : cA + (size_t)t2_ * kstep; const char* b2 = last ? nB : cB + (size_t)t2_ * kstep;
            const char* a3 = a2 + kstep; const char* b3 = b2 + kstep;
            if constexpr (GATHER) { if (last && has_next) { PG8_ROWS1(0, (ui + 1) & 1, nvalid); } }
            PG8_LDB(B0, 0, 0); PG8_LDB(B1, 0, 1); PG8_SCHED; PG8_LDA(At, 0, 0); PG8_STAGE_A(PG8_SA(1, 1), a1, 1, false);
            if constexpr (GATHER) { if (last && has_next) { PG8_ROWS1(1, (ui + 1) & 1, nvalid); } }
            PG8_WAIT_V(8); PG8_WAIT_L(0); PG8_BAR; PG8_MMA(0, 0, At, B0); PG8_MMA(0, 1, At, B1); PG8_BAR; PG8_SCHED;
            PG8_LDA(At, 0, 1); PG8_STAGE(PG8_SB(0, 0), b2, voffB); PG8_STAGE(PG8_SB(0, 1), b2 + hstep, voffB); PG8_STAGE_A(PG8_SA(0, 0), a2, 0, last);
            PG8_WAIT_V(8); PG8_WAIT_L(0); PG8_BAR; PG8_MMA(1, 0, At, B0); PG8_MMA(1, 1, At, B1); PG8_BAR; PG8_SCHED;
            PG8_LDB(B0, 1, 0); PG8_LDB(B1, 1, 1); PG8_SCHED; PG8_LDA(At, 1, 0); PG8_STAGE_A(PG8_SA(0, 1), a2, 1, last);
            PG8_WAIT_V(8); PG8_WAIT_L(0); PG8_BAR; PG8_MMA(0, 0, At, B0); PG8_MMA(0, 1, At, B1); PG8_BAR; PG8_SCHED;
            PG8_LDA(At, 1, 1); PG8_STAGE(PG8_SB(1, 0), b3, voffB); PG8_STAGE(PG8_SB(1, 1), b3 + hstep, voffB); PG8_STAGE_A(PG8_SA(1, 0), a3, 0, last);
            PG8_WAIT_V(8); PG8_WAIT_L(0); PG8_BAR; PG8_MMA(1, 0, At, B0); PG8_MMA(1, 1, At, B1); PG8_BAR; PG8_SCHED;
        }
        if constexpr (ALIGN_EPI) { if (wr == 0) PG8_BAR; }
        if constexpr (!Epi::AFTER_DRAIN) E(acc, cur, wr, wc, fr, fq, (const LAS int*)(lds + TBL_OFF + (ui & 1) * 1024), (const LAS float*)(lds + EPI_OFF + (ui & 1) * 2048));
        if (!has_next) break;
#pragma unroll
        for (int a = 0; a < 2; ++a)
#pragma unroll
            for (int b = 0; b < 2; ++b)
#pragma unroll
                for (int m = 0; m < 4; ++m)
#pragma unroll
                    for (int n = 0; n < 2; ++n) acc[a][b][m][n] = (f32x4){0.f, 0.f, 0.f, 0.f};
        cur = nxt; cA = nA; cB = nB; ++ui;
        if constexpr (ALIGN_EPI) { if (wr == 1) PG8_BAR; }
    }
    PG8_WAIT_V(0);
    if constexpr (!ALIGN_EPI) { if (wr == 0) PG8_BAR; }
    PG8_BAR;
    if constexpr (Epi::AFTER_DRAIN) E.drain(acc, cur, wr, wc, fr, fq, lds);
#undef PG8_SA
#undef PG8_SB
#undef PG8_STAGE
#undef PG8_STAGE_A
#undef PG8_LDA
#undef PG8_LDB
#undef PG8_MMA
#undef PG8_CAT
#undef PG8_WAIT_V
#undef PG8_WAIT_L
#undef PG8_BAR
#undef PG8_SCHED
#undef PG8_ROWS1
#undef PG8_TBL_DMA
}

struct EpiProj {
    static constexpr bool PERM = true, AFTER_DRAIN = false, PREFETCH = true; static constexpr int PF_WAVES = 4;
    bf16* O; const float* rstd;
    DI const float* pf_addr(const Unit& u, const LAS int*) const { return rstd + u.pm * BM + ((int)threadIdx.x & 255); }
    DI void operator()(const f32x4 (&acc)[2][2][4][2], const Unit& u, int wr, int wc, int fr, int fq, const LAS int*, const LAS float* ep) const {
        { int ln_ = (int)threadIdx.x; asm volatile("" : "+v"(ln_)); fr = ln_ & 15; fq = (ln_ >> 4) & 3; }
        const int row0 = u.pm * BM + wr * 64 + fr, col0 = u.pn * BM + wc * 32 + 8 * fq;
#pragma unroll
        for (int ai = 0; ai < 2; ++ai)
#pragma unroll
            for (int m = 0; m < 4; ++m) { const int row = row0 + ai * HALF + m * 16; const float rs = ep[wr * 64 + fr + ai * HALF + m * 16]; bf16* rowp = O + (size_t)row * NPROJ + col0;
#pragma unroll
                for (int bj = 0; bj < 2; ++bj) { const f32x4 v0 = mul4(acc[ai][bj][m][0], rs), v1 = mul4(acc[ai][bj][m][1], rs);
                    v4u w; w.x = cvt_pk_bf16(v0[0], v0[1]); w.y = cvt_pk_bf16(v0[2], v0[3]); w.z = cvt_pk_bf16(v1[0], v1[1]); w.w = cvt_pk_bf16(v1[2], v1[3]);
                    *(v4u*)(rowp + bj * HALF) = w; } }
    }
};
struct EpiX1 {
    static constexpr bool PERM = true, AFTER_DRAIN = false, PREFETCH = false;
    const float* x; bf16* X1; unsigned char* X1Q; float ascale;
    DI void operator()(const f32x4 (&acc)[2][2][4][2], const Unit& u, int wr, int wc, int fr, int fq, const LAS int*, const LAS float*) const {
        { int ln_ = (int)threadIdx.x; asm volatile("" : "+v"(ln_)); fr = ln_ & 15; fq = (ln_ >> 4) & 3; }
        const int row0 = u.pm * BM + wr * 64 + fr, col0 = u.pn * BM + wc * 32 + 8 * fq;
#pragma unroll
        for (int ai = 0; ai < 2; ++ai)
#pragma unroll
            for (int m = 0; m < 4; ++m) { const size_t off = (size_t)(row0 + ai * HALF + m * 16) * D + col0;
#pragma unroll
                for (int bj = 0; bj < 2; ++bj) { const f32x4 o0 = fma4(acc[ai][bj][m][0], ascale, *(const f32x4*)(x + off + bj * HALF)), o1 = fma4(acc[ai][bj][m][1], ascale, *(const f32x4*)(x + off + bj * HALF + 4));
                    *(v4u*)(X1 + off + bj * HALF) = __builtin_bit_cast(v4u, pack8(o0, o1));
                    v2u w; w.x = pk_fp8x4(o0.x, o0.y, o0.z, o0.w); w.y = pk_fp8x4(o1.x, o1.y, o1.z, o1.w); *(v2u*)(X1Q + off + bj * HALF) = w; }
                if (m & 1) asm volatile("" ::: "memory"); }
    }
};
struct EpiX1R {
    static constexpr bool PERM = true, AFTER_DRAIN = true, PREFETCH = false;
    const float* x; bf16* X1; unsigned char* X1Q; const bf16* WRT; float* PART; float* PSS; float ascale; const bf16* xb;
    DI void drain(const f32x4 (&acc)[2][2][4][2], const Unit& u, int wr, int wc, int fr, int fq, LAS unsigned char* lds) const {
        { int ln_ = (int)threadIdx.x; asm volatile("" : "+v"(ln_)); fr = ln_ & 15; fq = (ln_ >> 4) & 3; }
        LAS float* LG = (LAS float*)lds + wc * (256 * 33); LAS float* SS = (LAS float*)lds + 4 * 256 * 33 + wc * 256;
        const int row0 = u.pm * BM + wr * 64 + fr, col0 = u.pn * BM + wc * 32 + 8 * fq;
        bf16x8 Bw[2][4];
#pragma unroll
        for (int bj = 0; bj < 2; ++bj) { const bf16* wp = WRT + (size_t)fr * D + col0 + bj * HALF;
            Bw[bj][0] = __builtin_bit_cast(bf16x8, *(const v4u*)(wp)); Bw[bj][1] = __builtin_bit_cast(bf16x8, *(const v4u*)(wp + 32 * D));
            Bw[bj][2] = __builtin_bit_cast(bf16x8, *(const v4u*)(wp + 16 * D)); Bw[bj][3] = __builtin_bit_cast(bf16x8, *(const v4u*)(wp + 48 * D)); }
        f32x4 xq[8][4];
#define X1R_LOADX(i) do { const size_t off_ = (size_t)(row0 + ((i) >> 2) * HALF + ((i) & 3) * 16) * D + col0; const v4u xa_ = *(const v4u*)(xb + off_), xb_ = *(const v4u*)(xb + off_ + HALF);     \
        xq[i][0] = (f32x4){bf2f(xa_.x & 0xffffu), bf2f(xa_.x >> 16), bf2f(xa_.y & 0xffffu), bf2f(xa_.y >> 16)}; xq[i][1] = (f32x4){bf2f(xa_.z & 0xffffu), bf2f(xa_.z >> 16), bf2f(xa_.w & 0xffffu), bf2f(xa_.w >> 16)}; \
        xq[i][2] = (f32x4){bf2f(xb_.x & 0xffffu), bf2f(xb_.x >> 16), bf2f(xb_.y & 0xffffu), bf2f(xb_.y >> 16)}; xq[i][3] = (f32x4){bf2f(xb_.z & 0xffffu), bf2f(xb_.z >> 16), bf2f(xb_.w & 0xffffu), bf2f(xb_.w >> 16)}; } while (0)
        X1R_LOADX(0); X1R_LOADX(1);
        __syncthreads();
        v2u wq_[2] = {{0u, 0u}, {0u, 0u}};
#pragma unroll
        for (int ai = 0; ai < 2; ++ai)
#pragma unroll
            for (int m = 0; m < 4; ++m) { const size_t off = (size_t)(row0 + ai * HALF + m * 16) * D + col0; f32x4 t0 = {0.f, 0.f, 0.f, 0.f}, t1 = t0; float ss = 0.f;
                if (ai * 4 + m + 2 < 8) X1R_LOADX(ai * 4 + m + 2);
#pragma unroll
                for (int bj = 0; bj < 2; ++bj) { const f32x4 o0 = fma4(acc[ai][bj][m][0], ascale, xq[ai * 4 + m][2 * bj]), o1 = fma4(acc[ai][bj][m][1], ascale, xq[ai * 4 + m][2 * bj + 1]);
                    const bf16x8 A = pack8(o0, o1); const v4u aw = __builtin_bit_cast(v4u, A);
                    *(v4u*)(X1 + off + bj * HALF) = aw;
                    v2u w; w.x = pk_fp8x4(o0.x, o0.y, o0.z, o0.w); w.y = pk_fp8x4(o1.x, o1.y, o1.z, o1.w);
                    if (m & 1) { const int odd_ = fq & 1; *(v4u*)(X1Q + off - (size_t)(16 - 16 * odd_) * D - 8 * odd_ + bj * HALF) = widen16(wq_[bj], w); } else wq_[bj] = w;
#pragma unroll
                    for (int e = 0; e < 4; ++e) { const float lo = bf2f(aw[e] & 0xffffu), hi = bf2f(aw[e] >> 16); ss += lo * lo + hi * hi; }
                    t0 = mfma16(A, Bw[bj][0], t0); t0 = mfma16(A, Bw[bj][1], t0); t1 = mfma16(A, Bw[bj][2], t1); t1 = mfma16(A, Bw[bj][3], t1); }
                ss += __shfl_xor(ss, 16); ss += __shfl_xor(ss, 32);
                const int rl = ai * HALF + wr * 64 + m * 16;
                if (fq == 0) SS[rl + fr] = ss;
#pragma unroll
                for (int v = 0; v < 4; ++v) { LG[(rl + 4 * fq + v) * 33 + fr] = t0[v]; LG[(rl + 4 * fq + v) * 33 + 16 + fr] = t1[v]; }
                asm volatile("" ::: "memory"); }
#undef X1R_LOADX
        __syncthreads();
        {   const int t = (int)threadIdx.x, row = t >> 1, hf = t & 1; float* dst = PART + ((size_t)u.pn * T + (size_t)u.pm * BM + row) * 32 + 16 * hf; const LAS float* s = (const LAS float*)lds + row * 33 + 16 * hf;
#pragma unroll
            for (int i = 0; i < 4; ++i) { f32x4 a_;
#pragma unroll
                for (int e = 0; e < 4; ++e) a_[e] = (s[4 * i + e] + s[256 * 33 + 4 * i + e]) + (s[2 * 256 * 33 + 4 * i + e] + s[3 * 256 * 33 + 4 * i + e]);
                *(f32x4*)(dst + 4 * i) = a_; }
            const LAS float* sq = (const LAS float*)lds + 4 * 256 * 33;
            if (t < 256) PSS[(size_t)u.pn * T + (size_t)u.pm * BM + t] = (sq[t] + sq[256 + t]) + (sq[512 + t] + sq[768 + t]); }
        __syncthreads();
    }
};
struct EpiAct {
    static constexpr bool PERM = true, AFTER_DRAIN = false, PREFETCH = true; static constexpr int PF_WAVES = 8;
    unsigned char* ACT; const float* rstd2; const float* bgate; const float* bup;
    DI const float* pf_addr(const Unit& u, const LAS int* tb) const { const int t = (int)threadIdx.x;
        if (t < 256) { const int slot = tb[t]; const int tok = (t < u.valid) ? (slot >> 2) : 0; return rstd2 + tok; }
        const int j = t - 256; return (j < HALF ? bgate : bup) + ((size_t)u.e * DFF + u.pn * HALF + (j & (HALF - 1))); }
    DI void operator()(const f32x4 (&acc)[2][2][4][2], const Unit& u, int wr, int wc, int fr, int fq, const LAS int* tb, const LAS float* ep) const {
        { int ln_ = (int)threadIdx.x; asm volatile("" : "+v"(ln_)); fr = ln_ & 15; fq = (ln_ >> 4) & 3; }
        const int c = u.pn * HALF + wc * 32 + 8 * fq;
        const LAS float* bgp = ep + 256 + wc * 32 + 8 * fq; const LAS float* bup_ = bgp + HALF;
        constexpr float C1 = -1.702f * 1.4426950408889634f, C1I = 1.0f / C1;
        const f32x4 bg0 = *(const LAS f32x4*)bgp * C1, bg1 = *(const LAS f32x4*)(bgp + 4) * C1, bu0 = (*(const LAS f32x4*)bup_ + 1.0f) * C1I, bu1 = (*(const LAS f32x4*)(bup_ + 4) + 1.0f) * C1I;
        const int odd = fq & 1; v2u wprev = {0u, 0u};
#pragma unroll
        for (int ai = 0; ai < 2; ++ai)
#pragma unroll
            for (int m = 0; m < 4; ++m) { const int r = ai * HALF + wr * 64 + m * 16 + fr; const float rs = ep[r] * (WSCALE_INV / KREP7);
                f32x4 o[2];
#pragma unroll
                for (int n = 0; n < 2; ++n) { const f32x4 ga = acc[ai][0][m][n], ua = acc[ai][1][m][n], bgv = n ? bg1 : bg0, buv = n ? bu1 : bu0;
#pragma unroll
                    for (int h = 0; h < 2; ++h) { const f32x2 rsT = {rs * C1, rs * C1}, rsU = {rs * C1I, rs * C1I};
                        f32x2 t = (f32x2){ga[2 * h], ga[2 * h + 1]} * rsT + (f32x2){bgv[2 * h], bgv[2 * h + 1]}, u = (f32x2){ua[2 * h], ua[2 * h + 1]} * rsU + (f32x2){buv[2 * h], buv[2 * h + 1]};
                        t.x = fmaxf(t.x, 7.0f * C1); t.y = fmaxf(t.y, 7.0f * C1);
                        u.x = fminf(fmaxf(u.x, 8.0f * C1I), -6.0f * C1I); u.y = fminf(fmaxf(u.y, 8.0f * C1I), -6.0f * C1I);
                        f32x2 d; d.x = __builtin_amdgcn_exp2f(t.x); d.y = __builtin_amdgcn_exp2f(t.y); d = d + 1.0f;
                        f32x2 r; r.x = frcp(d.x); r.y = frcp(d.y);
                        const f32x2 ov = (u * t) * r; o[n][2 * h] = ov.x; o[n][2 * h + 1] = ov.y; } }
                v2u w; w.x = pk_fp8x4(o[0].x, o[0].y, o[0].z, o[0].w); w.y = pk_fp8x4(o[1].x, o[1].y, o[1].z, o[1].w);
                if (m & 1) { const v4u ww = widen16(wprev, w); *(v4u*)(ACT + ((size_t)u.pm * BM + r - 16 + 16 * odd) * DFF + c - 8 * odd) = ww; }
                else wprev = w; }
    }
};
struct EpiDown {
    static constexpr bool PERM = true, AFTER_DRAIN = false, PREFETCH = true; static constexpr int PF_WAVES = 8;
    unsigned char* Y4; const float* gatew; const float* bdown;
    DI const float* pf_addr(const Unit& u, const LAS int* tb) const { const int t = (int)threadIdx.x;
        if (t < 256) { const int slot = tb[t]; return gatew + (t < u.valid ? slot : 0); }
        return bdown + ((size_t)u.e * D + u.pn * BM + (t - 256)); }
    DI void operator()(const f32x4 (&acc)[2][2][4][2], const Unit& u, int wr, int wc, int fr, int fq, const LAS int* tb, const LAS float* ep) const {
        { int ln_ = (int)threadIdx.x; asm volatile("" : "+v"(ln_)); fr = ln_ & 15; fq = (ln_ >> 4) & 3; }
        const int c = u.pn * BM + wc * 32 + 8 * fq; const LAS float* bp = ep + 256 + wc * 32 + 8 * fq;
        f32x4 bd[2][2];
#pragma unroll
        for (int bj = 0; bj < 2; ++bj) { bd[bj][0] = *(const LAS f32x4*)(bp + bj * HALF); bd[bj][1] = *(const LAS f32x4*)(bp + bj * HALF + 4); }
        const int odd = fq & 1;
#pragma unroll
        for (int ai = 0; ai < 2; ++ai)
#pragma unroll
            for (int mp = 0; mp < 2; ++mp) { const int rA = ai * HALF + wr * 64 + (2 * mp) * 16 + fr, rB = rA + 16; const int sA = tb[rA], sB = tb[rB];
                const float gA = rA < u.valid ? ep[rA] * YSCALE : 0.f, gB = rB < u.valid ? ep[rB] * YSCALE : 0.f;
                const int rS = odd ? rB : rA, sS = odd ? sB : sA;
#pragma unroll
                for (int bj = 0; bj < 2; ++bj) {
                    const f32x4 a0 = mul4(fma4(acc[ai][bj][2 * mp][0], WSCALE_INV, bd[bj][0]), gA), a1 = mul4(fma4(acc[ai][bj][2 * mp][1], WSCALE_INV, bd[bj][1]), gA);
                    const f32x4 b0 = mul4(fma4(acc[ai][bj][2 * mp + 1][0], WSCALE_INV, bd[bj][0]), gB), b1 = mul4(fma4(acc[ai][bj][2 * mp + 1][1], WSCALE_INV, bd[bj][1]), gB);
                    const v4u w = widen16((v2u){pk_fp8x4(a0.x, a0.y, a0.z, a0.w), pk_fp8x4(a1.x, a1.y, a1.z, a1.w)}, (v2u){pk_fp8x4(b0.x, b0.y, b0.z, b0.w), pk_fp8x4(b1.x, b1.y, b1.z, b1.w)});
                    if (rS < u.valid) *(v4u*)(Y4 + (size_t)sS * D + c - 8 * odd + bj * HALF) = w; } }
    }
};
}

#define XB_TMO      128
#define XB_XCNT(j)  (256  + 64 * (j))
#define XB_XSUB(j)  (1280 + 64 * (j))
#define XB_XGEN(j)  (2304 + 64 * (j))
#define XB_TOP      3328
#define XB_TOPGEN   3392
#define XCD_BAR_WORDS 3456
#define XB_SPIN_CAP (1u << 18)
DI unsigned xb_ld(unsigned* p)              { return __hip_atomic_load(p, __ATOMIC_RELAXED, __HIP_MEMORY_SCOPE_AGENT); }
DI unsigned xb_add(unsigned* p, unsigned v) { return __hip_atomic_fetch_add(p, v, __ATOMIC_RELAXED, __HIP_MEMORY_SCOPE_AGENT); }
DI unsigned xb_xcc_id() { return (unsigned)__builtin_amdgcn_s_getreg((3 << 11) | 20) & 0xFu; }
#define XB_SPIN(cond, bar) do { unsigned _sp = 0; while (cond) { __builtin_amdgcn_s_sleep(1); \
    if ((++_sp & 255u) == 0u) { if (xb_ld(&(bar)[XB_TMO])) break; if (_sp > XB_SPIN_CAP) { atomicAdd(&(bar)[XB_TMO], 1u); break; } } } } while (0)
struct XcdBarrier { unsigned* bar; unsigned x; volatile LAS unsigned* st; };
DI XcdBarrier xcd_barrier_post(unsigned* bar, volatile LAS unsigned* st) {
    XcdBarrier b; b.bar = bar; b.x = xb_xcc_id(); b.st = st;
    if (threadIdx.x == 0) (void)xb_add(&bar[XB_XCNT(b.x)], 1u);
    return b;
}
DI void xcd_barrier_complete(unsigned* bar, unsigned x, unsigned& nloc, unsigned& nx) {
    const unsigned G = gridDim.x * gridDim.y * gridDim.z;
    unsigned sum, cnt, mine, sp = 0u;
    for (;;) {
        sum = 0u; cnt = 0u; mine = 0u;
#pragma unroll
        for (unsigned j = 0; j < 16; ++j) { const unsigned c = xb_ld(&bar[XB_XCNT(j)]); sum += c; cnt += (c > 0u) ? 1u : 0u; mine = (j == x) ? c : mine; }
        if (sum == G) break;
        __builtin_amdgcn_s_sleep(1);
        if ((++sp & 255u) == 0u) { if (xb_ld(&bar[XB_TMO])) break; if (sp > XB_SPIN_CAP) { atomicAdd(&bar[XB_TMO], 1u); break; } }
    }
    nloc = mine > 0u ? mine : 1u; nx = cnt > 0u ? cnt : 1u;
}
DI void xcd_barrier(const XcdBarrier& b) {
    asm volatile("s_waitcnt vmcnt(0)" ::: "memory");
    __syncthreads();
    if (threadIdx.x == 0) {
        unsigned* bar = b.bar;
        __builtin_amdgcn_s_waitcnt(0);
        unsigned nloc = b.st[0], nx = b.st[1];
        if (nloc == 0u) { xcd_barrier_complete(bar, b.x, nloc, nx); b.st[0] = nloc; b.st[1] = nx; }
        const unsigned old = xb_add(&bar[XB_XSUB(b.x)], 1u);
        const unsigned gen = old / nloc;
        if (old + 1u == (gen + 1u) * nloc) {
            __builtin_amdgcn_fence(__ATOMIC_RELEASE, "agent");
            asm volatile("s_waitcnt vmcnt(0)" ::: "memory");
            const unsigned og = xb_add(&bar[XB_TOP], 1u);
            const unsigned tg = og / nx;
            if (og + 1u == (tg + 1u) * nx) xb_add(&bar[XB_TOPGEN], 1u);
            else XB_SPIN(xb_ld(&bar[XB_TOPGEN]) == tg, bar);
            __builtin_amdgcn_fence(__ATOMIC_ACQUIRE, "agent");
            xb_add(&bar[XB_XGEN(b.x)], 1u);
            asm volatile("s_waitcnt vmcnt(0)" ::: "memory");
        } else {
            XB_SPIN(xb_ld(&bar[XB_XGEN(b.x)]) == gen, bar);
            __builtin_amdgcn_fence(__ATOMIC_ACQUIRE, "agent");
            asm volatile("s_waitcnt vmcnt(0)" ::: "memory");
        }
    }
    __syncthreads();
}

struct Args { const float* in[23]; float* out; unsigned char* ws; int ph_lo, ph_hi; };
enum { I_X = 0, I_NMIX, I_WIN, I_WAUP, I_BA, I_GNW, I_CW, I_CB, I_DTB, I_ALOG, I_DSSD, I_SNW, I_WOUT, I_NFFN, I_RW, I_RB, I_WG, I_BG, I_WU, I_BU, I_WD, I_BD, I_FNW };

struct Frame {
    LAS unsigned char* lds; int tid, lane, wave, G, bid;
    const float* const* in; float* out; unsigned char* ws;
};
#define WSP(T_, off) ((T_*)(F.ws + (off)))
#define LDS_WAIT() asm volatile("s_waitcnt lgkmcnt(0)" ::: "memory")

struct TrItem { const float* src; int sc; bf16* dst; unsigned char* dst8; int ldw, K; };
template <bool F8> DI void tr_load(const TrItem& t, f32x4 (&r)[16], int lane) {
    const float* p = t.src + (size_t)(lane >> 3) * t.ldw + 4 * (lane & 7);
#pragma unroll
    for (int i = 0; i < 8; ++i) r[i] = __builtin_nontemporal_load((const f32x4*)(p + (size_t)(8 * i) * t.ldw));
    if (F8) {
#pragma unroll
        for (int i = 8; i < 16; ++i) r[i] = __builtin_nontemporal_load((const f32x4*)(p + (size_t)(8 * i) * t.ldw)); }
}
template <bool F8> DI void tr_store(const TrItem& t, const f32x4 (&r)[16], LAS float* scr, const LAS float* scl, int lane) {
    if (F8) {
#pragma unroll
        for (int i = 0; i < 16; ++i) { LAS float* s = scr + (8 * i + (lane >> 3)) * 33 + 4 * (lane & 7); s[0] = r[i].x; s[1] = r[i].y; s[2] = r[i].z; s[3] = r[i].w; }
        LDS_WAIT(); asm volatile("" ::: "memory");
        const int c8 = lane & 7; f32x4 sc[4];
#pragma unroll
        for (int i = 0; i < 4; ++i) { sc[i] = (f32x4){WSCALE, WSCALE, WSCALE, WSCALE}; if (t.sc >= 0) sc[i] = *(const LAS f32x4*)(scl + t.sc + 16 * c8 + 4 * i); }
#pragma unroll
        for (int j = 0; j < 4; ++j) { const int n = (lane >> 3) + 8 * j; const LAS float* s = scr + (16 * c8) * 33 + n; v4u o;
            o.x = pk_fp8x4(s[0 * 33] * sc[0].x, s[1 * 33] * sc[0].y, s[2 * 33] * sc[0].z, s[3 * 33] * sc[0].w);
            o.y = pk_fp8x4(s[4 * 33] * sc[1].x, s[5 * 33] * sc[1].y, s[6 * 33] * sc[1].z, s[7 * 33] * sc[1].w);
            o.z = pk_fp8x4(s[8 * 33] * sc[2].x, s[9 * 33] * sc[2].y, s[10 * 33] * sc[2].z, s[11 * 33] * sc[2].w);
            o.w = pk_fp8x4(s[12 * 33] * sc[3].x, s[13 * 33] * sc[3].y, s[14 * 33] * sc[3].z, s[15 * 33] * sc[3].w);
            *(v4u*)(t.dst8 + (size_t)n * t.K + 16 * c8) = o; }
        LDS_WAIT(); asm volatile("" ::: "memory"); return; }
#pragma unroll
    for (int i = 0; i < 8; ++i) { LAS float* s = scr + (8 * i + (lane >> 3)) * 33 + 4 * (lane & 7); s[0] = r[i].x; s[1] = r[i].y; s[2] = r[i].z; s[3] = r[i].w; }
    LDS_WAIT(); asm volatile("" ::: "memory");
    const int c = lane & 7;
    f32x4 s0 = {1.f, 1.f, 1.f, 1.f}, s1 = s0;
    if (t.sc >= 0) { s0 = *(const LAS f32x4*)(scl + t.sc + 8 * c); s1 = *(const LAS f32x4*)(scl + t.sc + 8 * c + 4); }
#pragma unroll
    for (int j = 0; j < 4; ++j) { const int n = (lane >> 3) + 8 * j; const LAS float* s = scr + (8 * c) * 33 + n;
        v4u o; o.x = cvt_pk_bf16(s[0 * 33] * s0.x, s[1 * 33] * s0.y); o.y = cvt_pk_bf16(s[2 * 33] * s0.z, s[3 * 33] * s0.w); o.z = cvt_pk_bf16(s[4 * 33] * s1.x, s[5 * 33] * s1.y); o.w = cvt_pk_bf16(s[6 * 33] * s1.z, s[7 * 33] * s1.w);
        *(v4u*)(t.dst + (size_t)n * t.K + 8 * c) = o; }
    LDS_WAIT(); asm volatile("" ::: "memory");
}
constexpr int P0_SCR_BYTES = 128 * 33 * 4;
constexpr int P0_WX_OFF = 0, P0_WXS = 1032;
constexpr int P0_SCL_OFF = 8 * P0_SCR_BYTES;
static_assert(P0_SCL_OFF + 8192 <= MISC_OFF, "P0 LDS layout");
constexpr int P0_I_IN = 16 * 96, P0_I_O = 8 * 32, P0_I_E = 8 * 32;
constexpr int P0_NTR = P0_I_IN + P0_I_O + NE * 3 * P0_I_E, P0_NXG = T / 16;
DI TrItem p0_decode(const Frame& F, int it) {
    TrItem t; t.dst = nullptr; t.dst8 = nullptr; int r = it;
    if (r < NE * 3 * P0_I_E) {
        const int e = r / (3 * P0_I_E), which = (r / P0_I_E) % 3, rr = r % P0_I_E, kb = rr / 32, nb = rr % 32, c0 = nb * 32;
        if (which == 2) { t.src = F.in[I_WD] + (size_t)e * DFF * D + (size_t)(kb * 128) * D + c0; t.ldw = D; t.sc = -1; t.dst8 = WSP(unsigned char, WS_WD) + ((size_t)e * D + c0) * DFF + kb * 128; t.K = DFF; }
        else { const int drow = (c0 >> 7) * 256 + which * 128 + (c0 & 127);
            t.src = F.in[which ? I_WU : I_WG] + (size_t)e * D * DFF + (size_t)(kb * 128) * DFF + c0; t.ldw = DFF; t.sc = kb * 128; t.dst8 = WSP(unsigned char, WS_WGU) + ((size_t)e * 2048 + drow) * D + kb * 128; t.K = D; }
        return t; }
    r -= NE * 3 * P0_I_E;
    if (r < P0_I_IN) { const int kb = r / 96, nb = r % 96, j0 = nb * 32; const int col0 = j0 < 1536 ? j0 : (j0 < 2048 ? 1552 + (j0 - 1536) : 2064 + (j0 - 2048));
        t.src = F.in[I_WIN] + (size_t)(kb * 64) * D_IN + col0; t.ldw = D_IN; t.sc = 1024 + kb * 64; t.dst = WSP(bf16, WS_WIN) + (size_t)j0 * D + kb * 64; t.K = D; return t; }
    r -= P0_I_IN;
    { const int kb = r / 32, nb = r % 32; t.src = F.in[I_WOUT] + (size_t)(kb * 128) * D + nb * 32; t.ldw = D; t.sc = -1; t.dst8 = WSP(unsigned char, WS_WO) + (size_t)(nb * 32) * D + kb * 128; t.K = D; }
    return t;
}
DI void p0_experts_items(const Frame& F, LAS float* scr, const LAS float* SCL) {
    constexpr int NF8 = NE * 3 * P0_I_E; const int gw = F.bid * 8 + F.wave, NGW = F.G * 8;
    if (gw < NF8) {
        int it = gw; f32x4 ra[16], rb[16]; TrItem ca = p0_decode(F, it), cb;
        tr_load<true>(ca, ra, F.lane);
        while (it + 2 * NGW < NF8) {
            cb = p0_decode(F, it + NGW); tr_load<true>(cb, rb, F.lane); tr_store<true>(ca, ra, scr, SCL, F.lane);
            ca = p0_decode(F, it + 2 * NGW); tr_load<true>(ca, ra, F.lane); tr_store<true>(cb, rb, scr, SCL, F.lane);
            it += 2 * NGW; }
        if (it + NGW < NF8) { cb = p0_decode(F, it + NGW); tr_load<true>(cb, rb, F.lane); tr_store<true>(ca, ra, scr, SCL, F.lane); tr_store<true>(cb, rb, scr, SCL, F.lane); }
        else tr_store<true>(ca, ra, scr, SCL, F.lane);
    }
}
DI void p0_experts(const Frame& F) {
    LAS float* scr = (LAS float*)(F.lds + F.wave * P0_SCR_BYTES); LAS float* SCL = (LAS float*)(F.lds + P0_SCL_OFF);
    for (int i = F.tid; i < 1024; i += 512) SCL[i] = F.in[I_NFFN][i] * WSCALE;
    __syncthreads();
    p0_experts_items(F, scr, SCL);
    __syncthreads();
}
DI void p0_prologue(const Frame& F, bool experts_here) {
    LAS float* scr = (LAS float*)(F.lds + F.wave * P0_SCR_BYTES);
    LAS bf16* WX = (LAS bf16*)(F.lds + P0_WX_OFF);
    const float* x = F.in[I_X]; const float* nmix = F.in[I_NMIX]; const float* win = F.in[I_WIN];
    const int gw = F.bid * 8 + F.wave, NGW = F.G * 8;
    LAS float* SCL = (LAS float*)(F.lds + P0_SCL_OFF);
    constexpr int NF8 = NE * 3 * P0_I_E;
    const bool split = !experts_here && (F.G & 1) == 0 && F.G * 8 >= 2 * P0_NXG;
    const bool roleW = !split || F.bid < (F.G >> 1), roleX = !split || F.bid >= (F.G >> 1);
    if (roleW) {
        for (int i = F.tid; i < 1024; i += 512) { SCL[i] = F.in[I_NFFN][i] * WSCALE; SCL[1024 + i] = nmix[i]; }
        __syncthreads();
        if (experts_here) p0_experts_items(F, scr, SCL);
        const int nwv = split ? NGW / 2 : NGW;
        for (int it = NF8 + gw; it < P0_NTR; it += nwv) { const TrItem t = p0_decode(F, it); f32x4 r[16];
            if (t.dst8) { tr_load<true>(t, r, F.lane); tr_store<true>(t, r, scr, SCL, F.lane); } else { tr_load<false>(t, r, F.lane); tr_store<false>(t, r, scr, SCL, F.lane); } }
        for (int idx = F.bid * 512 + F.tid; idx < 32 * 1024; idx += (split ? (F.G >> 1) : F.G) * 512) { const int e = idx >> 10, k = idx & 1023; const float w = F.in[I_RW][(size_t)k * 32 + e] * F.in[I_NFFN][k];
            const unsigned hi = f2bf(w); bf16* wrt = WSP(bf16, WS_WRT); wrt[idx] = (bf16)hi; wrt[32 * 1024 + idx] = (bf16)f2bf(w - bf2f(hi)); }
    }
    if (!roleX) return;
    __syncthreads();
    {   f32x4 wv[2][6]; float sc[2];
#pragma unroll
        for (int rr = 0; rr < 2; ++rr) { const int k = F.tid + 512 * rr; const float* wr_ = win + (size_t)k * D_IN; sc[rr] = nmix[k];
#pragma unroll
            for (int i = 0; i < 4; ++i) wv[rr][i] = *(const f32x4*)(wr_ + 1536 + 4 * i);
            wv[rr][4] = *(const f32x4*)(wr_ + 3088); wv[rr][5] = *(const f32x4*)(wr_ + 3092); }
#pragma unroll
        for (int rr = 0; rr < 2; ++rr) { const int k = F.tid + 512 * rr;
#pragma unroll
            for (int i = 0; i < 6; ++i)
#pragma unroll
                for (int e = 0; e < 4; ++e) WX[(4 * i + e) * P0_WXS + k] = (bf16)f2bf(wv[rr][i][e] * sc[rr]);
#pragma unroll
            for (int j = 24; j < 32; ++j) WX[j * P0_WXS + k] = (bf16)0; }
    }
    __syncthreads();
    for (int g = NGW - 1 - gw; g < P0_NXG; g += NGW) {
        const int row0 = g * 16, r = F.lane & 15, q = F.lane >> 4;
        const float* xr = x + (size_t)(row0 + r) * D + 8 * q; bf16* xb = WSP(bf16, WS_XB) + (size_t)(row0 + r) * D + 8 * q;
        f32x4 a0 = {0.f, 0.f, 0.f, 0.f}, a1 = a0; float ss = 0.f;
        f32x4 xq[8][8];
#define P0_LOADX(gq) do { _Pragma("unroll") for (int kq = 0; kq < 4; ++kq) { xq[gq][2 * kq] = *(const f32x4*)(xr + 32 * (4 * (gq) + kq)); xq[gq][2 * kq + 1] = *(const f32x4*)(xr + 32 * (4 * (gq) + kq) + 4); } } while (0)
        P0_LOADX(0); P0_LOADX(1);
#pragma unroll
        for (int gq = 0; gq < 8; ++gq) {
            if (gq + 2 < 8) P0_LOADX(gq + 2);
#pragma unroll
            for (int kq = 0; kq < 4; ++kq) { const int kk = 4 * gq + kq;
                const f32x4 a = xq[gq][2 * kq], b = xq[gq][2 * kq + 1];
                ss += (a.x * a.x + a.y * a.y) + (a.z * a.z + a.w * a.w) + (b.x * b.x + b.y * b.y) + (b.z * b.z + b.w * b.w);
                const bf16x8 A = pack8(a, b);
                *(v4u*)(xb + 32 * kk) = __builtin_bit_cast(v4u, A);
                const bf16x8 B0 = *(const LAS bf16x8*)(WX + r * P0_WXS + 32 * kk + 8 * q), B1 = *(const LAS bf16x8*)(WX + (16 + r) * P0_WXS + 32 * kk + 8 * q);
                a0 = mfma16(A, B0, a0); a1 = mfma16(A, B1, a1);
                asm volatile("" ::: "memory"); }
        }
#undef P0_LOADX
        ss += __shfl_xor(ss, 16); ss += __shfl_xor(ss, 32);
        const float rstd = 1.0f / sqrtf(ss * (1.0f / D) + 1e-6f);
        if (q == 0) WSP(float, WS_RSTD1)[row0 + r] = rstd;
        float* ex = WSP(float, WS_EXTRA);
#pragma unroll
        for (int v = 0; v < 4; ++v) { const float rs = __shfl(rstd, 4 * q + v); ex[(size_t)(row0 + 4 * q + v) * 32 + r] = a0[v] * rs; ex[(size_t)(row0 + 4 * q + v) * 32 + 16 + r] = a1[v] * rs; }
    }
}

constexpr int TS = 68;
constexpr int NS = 132;
DI void ssd_tab_load(const Frame& F, int tok0, int g, float& dtraw, float& dtb, float& alog) {
    const int hd = 4 * g + (F.wave & 3);
    dtraw = WSP(float, WS_EXTRA)[(size_t)(tok0 + F.lane) * 32 + 16 + hd]; dtb = F.in[I_DTB][hd]; alog = F.in[I_ALOG][hd];
}
DI void ssd_tables(const Frame& F, int tok0, int g, LAS float* DTt, LAS float* ACt, LAS float* WGt, float* sdec_out  , float dtraw, float dtb, float alog) {
    if (F.wave < 4) { const int hl = F.wave;
        const float dtr = dtraw + dtb;
        const float dtv = softplus(dtr); const float a = -fexp(alog) * dtv; const float ac = wave_incl_scan(a, F.lane);
        const float ac63 = __shfl(ac, 63);
        DTt[hl * 64 + F.lane] = dtv; ACt[hl * 64 + F.lane] = ac; if (WGt) WGt[hl * 64 + F.lane] = fexp(ac63 - ac) * dtv;
        if (sdec_out && F.lane == 0) sdec_out[hl] = fexp(ac63); }
}
DI bf16x8 tr_frag(const LAS bf16* T_, int S, int ra, int rb, int col0, int lane) {
    const int rr = (lane & 15) >> 2, cc = col0 + 4 * (lane & 3);
    const s16x4 a = __builtin_amdgcn_ds_read_tr16_b64_v4i16((LAS s16x4*)(T_ + (ra + rr) * S + cc)), b = __builtin_amdgcn_ds_read_tr16_b64_v4i16((LAS s16x4*)(T_ + (rb + rr) * S + cc));
    return __builtin_shufflevector(a, b, 0, 1, 2, 3, 4, 5, 6, 7);
}
constexpr int RS = 528;
constexpr int QS = 72;
constexpr int VS = 144;
constexpr int XS = 272;
DI int ssd_srcc(int g, int cl) { return cl < 256 ? g * 256 + cl : (cl < 384 ? 512 + g * 128 + (cl - 256) : 768 + g * 128 + (cl - 384)); }
#define P2S_DECL(p) v4u p##0, p##1, p##2, p##3, p##4, p##5, p##6, p##7, p##8; f32x2 p##w0, p##w1, p##w2, p##w3, p##cb; float p##t0, p##t1, p##t2
#define P2S_ARGS(p) p##0, p##1, p##2, p##3, p##4, p##5, p##6, p##7, p##8, p##w0, p##w1, p##w2, p##w3, p##cb, p##t0, p##t1, p##t2
#define P2S_PARAMS(p, Q) Q v4u& p##0, Q v4u& p##1, Q v4u& p##2, Q v4u& p##3, Q v4u& p##4, Q v4u& p##5, Q v4u& p##6, Q v4u& p##7, Q v4u& p##8, Q f32x2& p##w0, Q f32x2& p##w1, Q f32x2& p##w2, Q f32x2& p##w3, Q f32x2& p##cb, Q float& p##t0, Q float& p##t1, Q float& p##t2
DI void p2_ssd_load(const Frame& F, int b, int c, int g, P2S_PARAMS(r, )) {
    const int tok0 = b * SEQ + c * CH; const bf16* PROJ = WSP(bf16, WS_PROJ);
    ssd_tab_load(F, tok0, g, rt0, rt1, rt2);
    const int cp = F.tid & 255, s0c = ssd_srcc(g, 2 * cp); const float* cw = F.in[I_CW]; const float* cbp = F.in[I_CB];
    rw0 = *(const f32x2*)(cw + s0c); rw1 = *(const f32x2*)(cw + 1024 + s0c); rw2 = *(const f32x2*)(cw + 2048 + s0c); rw3 = *(const f32x2*)(cw + 3072 + s0c); rcb = *(const f32x2*)(cbp + s0c);
#define P2S_LD(i, dst) { const int ch = F.tid + 512 * (i), row = ch >> 6, cc = ch & 63; const bool ok = (c > 0 || row >= 3); const int rr = (ch < 67 * 64) ? row : 66; \
        const v4u t_ = *(const v4u*)(PROJ + (size_t)(tok0 + (ok ? rr - 3 : 0)) * NPROJ + PC_XBC + ssd_srcc(g, 8 * cc)); dst = ok ? t_ : (v4u){0u, 0u, 0u, 0u}; }
    P2S_LD(0, r0) P2S_LD(1, r1) P2S_LD(2, r2) P2S_LD(3, r3) P2S_LD(4, r4) P2S_LD(5, r5) P2S_LD(6, r6) P2S_LD(7, r7) P2S_LD(8, r8)
#undef P2S_LD
}
template <bool PF> DI void p2_ssd_unit(const Frame& F, int b, int c, int g, P2S_PARAMS(v, const), int nu, P2S_PARAMS(n, )) {
    LAS bf16* RAW = (LAS bf16*)(F.lds);
    LAS bf16* OUT = (LAS bf16*)(F.lds + 67 * RS * 2);
    LAS float* DTt = (LAS float*)(F.lds + 131 * RS * 2);
    LAS float* ACt = DTt + 256; LAS float* WGt = ACt + 256;
    const int tok0 = b * SEQ + c * CH; const int l15 = F.lane & 15, q = F.lane >> 4;
    const bf16* PROJ = WSP(bf16, WS_PROJ); bf16* XBCA = WSP(bf16, WS_XBCA);
    const int cp = F.tid & 255, th = F.tid >> 8; const f32x2 w0 = vw0, w1 = vw1, w2 = vw2, w3 = vw3, cb = vcb;
    {   ssd_tables(F, tok0, g, DTt, ACt, WGt, WSP(float, WS_SDEC) + ((size_t)(b * NCH + c) * 8 + 4 * g), vt0, vt1, vt2);
#define P2S_ST(i, src) { const int ch = F.tid + 512 * (i), row = ch >> 6, cc = ch & 63; if (ch < 67 * 64) *(LAS v4u*)(RAW + row * RS + 8 * cc) = (src); }
        P2S_ST(0, v0) P2S_ST(1, v1) P2S_ST(2, v2) P2S_ST(3, v3) P2S_ST(4, v4) P2S_ST(5, v5) P2S_ST(6, v6) P2S_ST(7, v7) P2S_ST(8, v8)
#undef P2S_ST
    }
    if (PF) p2_ssd_load(F, nu >> 6, (nu & 63) >> 1, nu & 1, P2S_ARGS(n));
    __syncthreads();
    {
        const LAS unsigned* rp = (const LAS unsigned*)(RAW + (32 * th) * RS + 2 * cp); LAS unsigned* op = (LAS unsigned*)(OUT + (32 * th) * RS + 2 * cp);
        unsigned u = rp[0]; f32x2 xm3 = {bf2f(u & 0xffffu), bf2f(u >> 16)}; u = rp[RS / 2]; f32x2 xm2 = {bf2f(u & 0xffffu), bf2f(u >> 16)}; u = rp[RS]; f32x2 xm1 = {bf2f(u & 0xffffu), bf2f(u >> 16)};
#pragma unroll 8
        for (int t = 0; t < 32; ++t) { u = rp[(t + 3) * (RS / 2)]; const f32x2 xin = {bf2f(u & 0xffffu), bf2f(u >> 16)};
            f32x2 y = cb + w0 * xm3 + w1 * xm2 + w2 * xm1 + w3 * xin; xm3 = xm2; xm2 = xm1; xm1 = xin;
            op[t * (RS / 2)] = cvt_pk_bf16(silu(y.x), silu(y.y)); }
    }
    __syncthreads();
    {
#pragma unroll
        for (int i = 0; i < 8; ++i) { const int ch = F.tid + 512 * i, row = ch >> 6, cc = ch & 63; *(v4u*)(XBCA + (size_t)(tok0 + row) * 1024 + ssd_srcc(g, 8 * cc)) = *(const LAS v4u*)(OUT + row * RS + 8 * cc); }
    }
    {
        const int hl = F.wave >> 1, ph = F.wave & 1;
        f32x4 acc[8][2];
#pragma unroll
        for (int nn = 0; nn < 8; ++nn) { acc[nn][0] = (f32x4){0.f, 0.f, 0.f, 0.f}; acc[nn][1] = acc[nn][0]; }
#pragma unroll
        for (int kk = 0; kk < 2; ++kk) { bf16x8 Bop[2]; const int j0 = 32 * kk + 8 * q;
            const f32x4 w0 = *(const LAS f32x4*)(WGt + hl * 64 + j0), w1 = *(const LAS f32x4*)(WGt + hl * 64 + j0 + 4);
#pragma unroll
            for (int mp = 0; mp < 2; ++mp) { const bf16x8 raw = tr_frag(OUT, RS, j0, j0 + 4, hl * 64 + 32 * ph + 16 * mp, F.lane);
                f32x4 lo, hi;
#pragma unroll
                for (int j = 0; j < 4; ++j) { lo[j] = bf2f((unsigned short)raw[j]) * w0[j]; hi[j] = bf2f((unsigned short)raw[4 + j]) * w1[j]; }
                Bop[mp] = pack8(lo, hi); }
#pragma unroll
            for (int nn = 0; nn < 8; ++nn) { const bf16x8 Aop = tr_frag(OUT, RS, j0, j0 + 4, 256 + 16 * nn, F.lane);
                acc[nn][0] = mfma16(Aop, Bop[0], acc[nn][0]); acc[nn][1] = mfma16(Aop, Bop[1], acc[nn][1]); } }
        bf16* st = WSP(bf16, WS_LS) + ((size_t)(b * NCH + c) * 8 + 4 * g + hl) * 8192;
#pragma unroll
        for (int nn = 0; nn < 8; nn += 2)
#pragma unroll
            for (int mp = 0; mp < 2; ++mp) *(v4u*)(st + (32 * ph + 16 * mp + l15) * 128 + 16 * (nn + (q & 1)) + 4 * (q - (q & 1))) = widen16(pack4(acc[nn][mp]), pack4(acc[nn + 1][mp]));
    }
    __syncthreads();
}
#define P2G_DECL(p) v4u p##q, p##k, p##v0, p##v1; float p##a0, p##a1, p##u0, p##u1, p##ba
#define P2G_ARGS(p) p##q, p##k, p##v0, p##v1, p##a0, p##a1, p##u0, p##u1, p##ba
#define P2G_PARAMS(p, Q) Q v4u& p##q, Q v4u& p##k, Q v4u& p##v0, Q v4u& p##v1, Q float& p##a0, Q float& p##a1, Q float& p##u0, Q float& p##u1, Q float& p##ba
DI void p2_gla_load(const Frame& F, int b, int c, int h, P2G_PARAMS(r, )) {
    const int tok0 = b * SEQ + c * CH; const bf16* PROJ = WSP(bf16, WS_PROJ);
    { const int i = F.tid; ra0 = WSP(float, WS_EXTRA)[(size_t)(tok0 + (i >> 4)) * 32 + (i & 15)]; ru0 = F.in[I_WAUP][(size_t)(i >> 6) * 256 + h * 64 + (i & 63)]; }
    { const int i = F.tid + 512; ra1 = WSP(float, WS_EXTRA)[(size_t)(tok0 + (i >> 4)) * 32 + (i & 15)]; ru1 = F.in[I_WAUP][(size_t)(i >> 6) * 256 + h * 64 + (i & 63)]; }
    rba = F.in[I_BA][h * 64 + (F.tid & 63)];
    const int t = F.tid >> 3, seg = F.tid & 7; const bf16* src = PROJ + (size_t)(tok0 + t) * NPROJ + h * 64 + seg * 8;
    rq = *(const v4u*)(src + PC_Q); rk = *(const v4u*)(src + PC_K);
    const bf16* vs = PROJ + (size_t)(tok0 + t) * NPROJ + PC_V + h * 128 + seg * 16; rv0 = *(const v4u*)vs; rv1 = *(const v4u*)(vs + 8);
}
template <bool PF> DI void p2_gla_unit(const Frame& F, int b, int c, int h, P2G_PARAMS(v, const), int nu, P2G_PARAMS(n, )) {
    LAS bf16* QN = (LAS bf16*)(F.lds);
    LAS bf16* KN = (LAS bf16*)(F.lds + 64 * QS * 2);
    LAS bf16* VN = (LAS bf16*)(F.lds + 128 * QS * 2);
    LAS float* AL = (LAS float*)(F.lds + 128 * QS * 2 + 64 * VS * 2);
    LAS float* WU = AL + 1024;
    LAS float* TOT = WU + 1024;
    LAS float* DECL = TOT + 512;
    const int tok0 = b * SEQ + c * CH; const int l15 = F.lane & 15, q = F.lane >> 4;
    const bf16* PROJ = WSP(bf16, WS_PROJ);
    const float ba = vba;
    {   const int t = F.tid >> 3, seg = F.tid & 7;
        AL[F.tid] = va0; AL[F.tid + 512] = va1; WU[F.tid] = vu0; WU[F.tid + 512] = vu1;
        *(LAS v4u*)(QN + t * QS + seg * 8) = vq; *(LAS v4u*)(KN + t * QS + seg * 8) = vk; *(LAS v4u*)(VN + t * VS + seg * 16) = vv0; *(LAS v4u*)(VN + t * VS + seg * 16 + 8) = vv1; }
    if (PF) { const int v_ = nu - 512; p2_gla_load(F, v_ >> 7, (v_ & 127) >> 2, v_ & 3, P2G_ARGS(n)); }
    __syncthreads();
    const int d = F.tid & 63, tg = F.tid >> 6;
    float pc[8];
    {   float wu[16];
#pragma unroll
        for (int r = 0; r < 16; ++r) wu[r] = WU[r * 64 + d];
        float run = 0.f;
#pragma unroll
        for (int tt = 0; tt < 8; ++tt) { const int t = tg * 8 + tt; float z = ba;
#pragma unroll
            for (int r = 0; r < 16; ++r) z += AL[t * 16 + r] * wu[r];
            run += logsigmoid(z) * (1.0f / 16.0f); pc[tt] = run; }
        TOT[tg * 64 + d] = run; }
    __syncthreads();
    {   float pre = 0.f, tot = 0.f;
#pragma unroll
        for (int gI = 0; gI < 8; ++gI) { const float tv = TOT[gI * 64 + d]; tot += tv; if (gI < tg) pre += tv; }
        if (tg == 0) { const float dc = fexp(tot); DECL[d] = dc; WSP(float, WS_DECG)[((size_t)(b * NCH + c) * 4 + h) * 64 + d] = dc; }
#pragma unroll
        for (int tt = 0; tt < 8; ++tt) { const int t = tg * 8 + tt; const float bc = pc[tt] + pre; const float qv = bf2f(QN[t * QS + d]), kv = bf2f(KN[t * QS + d]);
            QN[t * QS + d] = (bf16)f2bf(qv * fexp(bc) * 0.125f); KN[t * QS + d] = (bf16)f2bf(kv * fexp(-bc)); }
    }
    __syncthreads();
    {   const int t = F.tid >> 3, seg = F.tid & 7; bf16* dst = WSP(bf16, WS_QKT) + (size_t)(tok0 + t) * 512 + h * 64 + seg * 8;
        *(v4u*)dst = *(const LAS v4u*)(QN + t * QS + seg * 8); *(v4u*)(dst + 256) = *(const LAS v4u*)(KN + t * QS + seg * 8); }
    {
        f32x4 acc[4];
#pragma unroll
        for (int md = 0; md < 4; ++md) acc[md] = (f32x4){0.f, 0.f, 0.f, 0.f};
#pragma unroll
        for (int kk = 0; kk < 2; ++kk) { const int j0 = 32 * kk + 8 * q; const bf16x8 Bop = tr_frag(VN, VS, j0, j0 + 4, 16 * F.wave, F.lane);
#pragma unroll
            for (int md = 0; md < 4; ++md) { const bf16x8 Aop = tr_frag(KN, QS, j0, j0 + 4, 16 * md, F.lane); acc[md] = mfma16(Aop, Bop, acc[md]); } }
        bf16* st = WSP(bf16, WS_LG) + ((size_t)(b * NCH + c) * 4 + h) * 8192 + (16 * F.wave + l15) * 64;
#pragma unroll
        for (int md = 0; md < 4; md += 2) { const f32x4 dc0 = *(const LAS f32x4*)(DECL + 16 * md + 4 * q), dc1 = *(const LAS f32x4*)(DECL + 16 * md + 16 + 4 * q);
            *(v4u*)(st + 16 * (md + (q & 1)) + 4 * (q - (q & 1))) = widen16(pack4(acc[md] * dc0), pack4(acc[md + 1] * dc1)); }
    }
    __syncthreads();
}

DI void p3_scan(const Frame& F) {
    constexpr int NG = 32 * 1024, NS_ = 64 * 1024;
    LAS float* DT = (LAS float*)(F.lds) + F.wave * 2048;
    for (int blk = F.wave * F.G + F.bid; blk * 64 < NG + NS_; blk += 8 * F.G) { const int it = blk * 64 + F.lane;
        f32x4 S0 = {0.f, 0.f, 0.f, 0.f}, S1 = S0;
        v4u lq[32];
        if (it < NG) { const int seq = it >> 10, e8 = it & 1023, b = seq >> 2, h = seq & 3, d0 = (e8 & 7) * 8;
            const size_t o = ((size_t)(b * NCH) * 4 + h) * 8192 + e8 * 8; const bf16* lp = WSP(bf16, WS_LG) + o; unsigned char* p = WSP(unsigned char, WS_STG) + o;
#pragma unroll
            for (int c = 0; c < NCH; ++c) lq[c] = *(const v4u*)(lp + (size_t)c * 4 * 8192);
            {   const float* dsrc = WSP(float, WS_DECG) + ((size_t)(b * NCH) * 4 + h) * 64;
                f32x4 dv[8];
#pragma unroll
                for (int k = 0; k < 8; ++k) { const int f4 = F.lane + 64 * k, c = f4 >> 4, dq = f4 & 15; dv[k] = *(const f32x4*)(dsrc + (size_t)c * 256 + 4 * dq); }
#pragma unroll
                for (int k = 0; k < 8; ++k) *(LAS f32x4*)(DT + 4 * (F.lane + 64 * k)) = dv[k]; }
#pragma unroll
            for (int c = 0; c < NCH; ++c) { v2u o8;
                o8.x = pk_fp8x4(sat8(S0.x * SGSCALE), sat8(S0.y * SGSCALE), sat8(S0.z * SGSCALE), sat8(S0.w * SGSCALE)); o8.y = pk_fp8x4(sat8(S1.x * SGSCALE), sat8(S1.y * SGSCALE), sat8(S1.z * SGSCALE), sat8(S1.w * SGSCALE));
                *(v2u*)(p + (size_t)c * 4 * 8192) = o8;
                const f32x4 dc0 = *(const LAS f32x4*)(DT + c * 64 + d0), dc1 = *(const LAS f32x4*)(DT + c * 64 + d0 + 4); const v4u l = lq[c];
                S0.x = S0.x * dc0.x + bf2f(l.x & 0xffffu); S0.y = S0.y * dc0.y + bf2f(l.x >> 16); S0.z = S0.z * dc0.z + bf2f(l.y & 0xffffu); S0.w = S0.w * dc0.w + bf2f(l.y >> 16);
                S1.x = S1.x * dc1.x + bf2f(l.z & 0xffffu); S1.y = S1.y * dc1.y + bf2f(l.z >> 16); S1.z = S1.z * dc1.z + bf2f(l.w & 0xffffu); S1.w = S1.w * dc1.w + bf2f(l.w >> 16); }
        } else { const int i2 = it - NG, seq = i2 >> 10, e8 = i2 & 1023, b = seq >> 3, hd = seq & 7;
            const size_t o = ((size_t)(b * NCH) * 8 + hd) * 8192 + e8 * 8; const bf16* lp = WSP(bf16, WS_LS) + o; unsigned char* p = WSP(unsigned char, WS_STS) + o;
#pragma unroll
            for (int c = 0; c < NCH; ++c) lq[c] = *(const v4u*)(lp + (size_t)c * 8 * 8192);
            const float dcl = WSP(float, WS_SDEC)[(size_t)(b * NCH + (F.lane & 31)) * 8 + hd];
#pragma unroll
            for (int c = 0; c < NCH; ++c) { v2u o8; const float dc = __int_as_float(__builtin_amdgcn_readlane(__float_as_int(dcl), c));
                o8.x = pk_fp8x4(sat8(S0.x * SSSCALE), sat8(S0.y * SSSCALE), sat8(S0.z * SSSCALE), sat8(S0.w * SSSCALE)); o8.y = pk_fp8x4(sat8(S1.x * SSSCALE), sat8(S1.y * SSSCALE), sat8(S1.z * SSSCALE), sat8(S1.w * SSSCALE));
                *(v2u*)(p + (size_t)c * 8 * 8192) = o8;
                const v4u l = lq[c];
                S0.x = S0.x * dc + bf2f(l.x & 0xffffu); S0.y = S0.y * dc + bf2f(l.x >> 16); S0.z = S0.z * dc + bf2f(l.y & 0xffffu); S0.w = S0.w * dc + bf2f(l.y >> 16);
                S1.x = S1.x * dc + bf2f(l.z & 0xffffu); S1.y = S1.y * dc + bf2f(l.z >> 16); S1.z = S1.z * dc + bf2f(l.w & 0xffffu); S1.w = S1.w * dc + bf2f(l.w >> 16); }
        }
    }
}

DI void p4_gla_load(const Frame& F, int b, int c, int h, v4u& qv, v4u& kv, v4u& v0, v4u& v1) {
    const int tok0 = b * SEQ + c * CH; const int t = F.tid >> 3, seg = F.tid & 7; const bf16* src = WSP(bf16, WS_QKT) + (size_t)(tok0 + t) * 512 + h * 64 + seg * 8;
    qv = *(const v4u*)(src); kv = *(const v4u*)(src + 256);
    const bf16* vs = WSP(bf16, WS_PROJ) + (size_t)(tok0 + t) * NPROJ + PC_V + h * 128 + seg * 16; v0 = *(const v4u*)vs; v1 = *(const v4u*)(vs + 8);
}
template <bool PF> DI void p4_gla_unit(const Frame& F, int b, int c, int h, const v4u& qv, const v4u& kv, const v4u& v0, const v4u& v1, int nu, v4u& nq, v4u& nk, v4u& nv0, v4u& nv1) {
    LAS bf16* QL = (LAS bf16*)(F.lds);
    LAS bf16* KL = (LAS bf16*)(F.lds + 64 * QS * 2);
    LAS bf16* VN = (LAS bf16*)(F.lds + 128 * QS * 2);
    LAS float* SSQ = (LAS float*)(F.lds + 128 * QS * 2 + 64 * VS * 2);
    const int tok0 = b * SEQ + c * CH; const int l15 = F.lane & 15, q = F.lane >> 4;
    const bf16* PROJ = WSP(bf16, WS_PROJ);
    {   const int t = F.tid >> 3, seg = F.tid & 7;
        *(LAS v4u*)(QL + t * QS + seg * 8) = qv; *(LAS v4u*)(KL + t * QS + seg * 8) = kv; *(LAS v4u*)(VN + t * VS + seg * 16) = v0; *(LAS v4u*)(VN + t * VS + seg * 16 + 8) = v1; }
    const int ri = F.wave & 3, vh = F.wave >> 2;
    const unsigned char* st = WSP(unsigned char, WS_STG) + ((size_t)(b * NCH + c) * 4 + h) * 8192;
    v4u sin_[4]; v2u gv_[4];
#pragma unroll
    for (int mv = 0; mv < 4; ++mv) sin_[mv] = *(const v4u*)(st + (64 * vh + 16 * mv + l15) * 64 + 16 * q);
    {   const bf16* gp_ = PROJ + (size_t)(tok0 + 16 * ri + l15) * NPROJ + PC_G + h * 128;
#pragma unroll
        for (int mv = 0; mv < 4; ++mv) gv_[mv] = *(const v2u*)(gp_ + 64 * vh + 16 * mv + 4 * q); }
    f32x4 nwv_[4];
#pragma unroll
    for (int mv = 0; mv < 4; ++mv) nwv_[mv] = *(const f32x4*)(F.in[I_GNW] + h * 128 + 64 * vh + 16 * mv + 4 * q);
    if (PF) { const int v = nu - 512; p4_gla_load(F, v >> 7, (v & 127) >> 2, v & 3, nq, nk, nv0, nv1); }
    __syncthreads();
    f32x4 sc[4];
#pragma unroll
    for (int mj = 0; mj < 4; ++mj) sc[mj] = (f32x4){0.f, 0.f, 0.f, 0.f};
#pragma unroll
    for (int mj = 0; mj < 4; ++mj) if (mj <= ri) {
#pragma unroll
        for (int kk = 0; kk < 2; ++kk) { const bf16x8 A = lds_frag(KL + (16 * mj + l15) * QS + 32 * kk + 8 * q), B = lds_frag(QL + (16 * ri + l15) * QS + 32 * kk + 8 * q); sc[mj] = mfma16(A, B, sc[mj]); }
        if (mj == ri) {
#pragma unroll
            for (int v = 0; v < 4; ++v) if (4 * q + v > l15) sc[mj][v] = 0.f; } }
    f32x4 acc[4];
#pragma unroll
    for (int mv = 0; mv < 4; ++mv) acc[mv] = (f32x4){0.f, 0.f, 0.f, 0.f};
#pragma unroll
    for (int kp = 0; kp < 2; ++kp) if (2 * kp <= ri) { const bf16x8 Bop = pack8(sc[2 * kp], sc[2 * kp + 1]);
#pragma unroll
        for (int mv = 0; mv < 4; ++mv) acc[mv] = mfma16(tr_frag(VN, VS, 32 * kp + 4 * q, 32 * kp + 16 + 4 * q, 64 * vh + 16 * mv, F.lane), Bop, acc[mv]); }
#pragma unroll
    for (int kk = 0; kk < 2; ++kk) { const bf16x8 Bq = lds_frag(QL + (16 * ri + l15) * QS + 16 * q + 8 * kk);
#pragma unroll
        for (int mv = 0; mv < 4; ++mv) acc[mv] = mfma16(fp8x8_to_bf16(sin_[mv][2 * kk], sin_[mv][2 * kk + 1], 1.0f / SGSCALE), Bq, acc[mv]); }
    float ss = 0.f;
#pragma unroll
    for (int mv = 0; mv < 4; ++mv) ss += (acc[mv].x * acc[mv].x + acc[mv].y * acc[mv].y) + (acc[mv].z * acc[mv].z + acc[mv].w * acc[mv].w);
    ss += __shfl_xor(ss, 16); ss += __shfl_xor(ss, 32);
    if (q == 0) SSQ[vh * 64 + 16 * ri + l15] = ss;
    __syncthreads();
    {   const int i = 16 * ri + l15; const float rs = 1.0f / sqrtf((SSQ[i] + SSQ[64 + i]) * (1.0f / 128.0f) + 1e-5f);
        unsigned char* op = WSP(unsigned char, WS_MIXED) + (size_t)(tok0 + i) * D + h * 128;
        unsigned pw[4];
#pragma unroll
        for (int mv = 0; mv < 4; ++mv) { const v2u gv = gv_[mv]; const f32x4 w = nwv_[mv];
            f32x4 o; o.x = acc[mv].x * rs * w.x * silu(bf2f(gv.x & 0xffffu)); o.y = acc[mv].y * rs * w.y * silu(bf2f(gv.x >> 16));
            o.z = acc[mv].z * rs * w.z * silu(bf2f(gv.y & 0xffffu)); o.w = acc[mv].w * rs * w.w * silu(bf2f(gv.y >> 16));
            pw[mv] = pk_fp8s(o, MSCALE); }
#pragma unroll
        for (int mv = 0; mv < 4; mv += 2) *(v2u*)(op + 64 * vh + 16 * (mv + (q & 1)) + 4 * (q - (q & 1))) = widen8(pw[mv], pw[mv + 1]); }
    __syncthreads();
}
DI void p4_ssd_load(const Frame& F, int b, int c, int g, v4u& x0, v4u& x1, v4u& x2, v4u& x3, v4u& b0, v4u& b1, v4u& c0, v4u& c1, float& tdt, float& tb, float& ta) {
    const int tok0 = b * SEQ + c * CH; const bf16* XBCA = WSP(bf16, WS_XBCA);
    ssd_tab_load(F, tok0, g, tdt, tb, ta);
#define P4S_X(i) (*(const v4u*)(XBCA + (size_t)(tok0 + ((F.tid + 512 * (i)) >> 5)) * 1024 + g * 256 + 8 * ((F.tid + 512 * (i)) & 31)))
    x0 = P4S_X(0); x1 = P4S_X(1); x2 = P4S_X(2); x3 = P4S_X(3);
#undef P4S_X
    const int t = F.tid >> 3, seg = F.tid & 7; const bf16* bs = XBCA + (size_t)(tok0 + t) * 1024 + 512 + g * 128 + seg * 16;
    b0 = *(const v4u*)bs; b1 = *(const v4u*)(bs + 8); c0 = *(const v4u*)(bs + 256); c1 = *(const v4u*)(bs + 264);
}
template <bool PF> DI void p4_ssd_unit(const Frame& F, int b, int c, int g, const v4u& x0, const v4u& x1, const v4u& x2, const v4u& x3, const v4u& b0, const v4u& b1, const v4u& c0, const v4u& c1, float tb_dt, float tb_b, float tb_a,
                                       int nu, v4u& nx0, v4u& nx1, v4u& nx2, v4u& nx3, v4u& nb0, v4u& nb1, v4u& nc0, v4u& nc1, float& ntdt, float& ntb, float& nta) {
    LAS bf16* XN = (LAS bf16*)(F.lds);
    LAS bf16* BL = (LAS bf16*)(F.lds + 64 * XS * 2);
    LAS bf16* CL = (LAS bf16*)(F.lds + 64 * XS * 2 + 64 * VS * 2);
    LAS float* CB = (LAS float*)(F.lds + 64 * XS * 2 + 128 * VS * 2);
    LAS float* DTt = CB + 64 * TS;
    LAS float* ACt = DTt + 256; LAS float* SSQ = ACt + 256;
    const int tok0 = b * SEQ + c * CH; const int l15 = F.lane & 15, q = F.lane >> 4;
    const bf16* PROJ = WSP(bf16, WS_PROJ); const bf16* XBCA = WSP(bf16, WS_XBCA);
    const int hl = F.wave >> 1, ph = F.wave & 1, hd = 4 * g + hl;
    const unsigned char* st = WSP(unsigned char, WS_STS) + ((size_t)(b * NCH + c) * 8 + hd) * 8192;
    v4u sin_[2][2]; v2u zv_[4][2];
    {   const int t = F.tid >> 3, seg = F.tid & 7;
#pragma unroll
        for (int pr = 0; pr < 2; ++pr)
#pragma unroll
            for (int mp = 0; mp < 2; ++mp) sin_[pr][mp] = *(const v4u*)(st + (32 * ph + 16 * mp + l15) * 128 + 64 * pr + 16 * q);
#pragma unroll
        for (int ni = 0; ni < 4; ++ni)
#pragma unroll
            for (int mp = 0; mp < 2; ++mp) zv_[ni][mp] = *(const v2u*)(PROJ + (size_t)(tok0 + 16 * ni + l15) * NPROJ + PC_Z + g * 256 + hl * 64 + 32 * ph + 16 * mp + 4 * q);
        ssd_tables(F, tok0, g, DTt, ACt, nullptr, nullptr, tb_dt, tb_b, tb_a);
#define P4S_W(i, xv) { const int ch = F.tid + 512 * (i), tt = ch >> 5, cc = ch & 31; *(LAS v4u*)(XN + tt * XS + 8 * cc) = (xv); }
        P4S_W(0, x0) P4S_W(1, x1) P4S_W(2, x2) P4S_W(3, x3)
#undef P4S_W
        *(LAS v4u*)(BL + t * VS + seg * 16) = b0; *(LAS v4u*)(BL + t * VS + seg * 16 + 8) = b1; *(LAS v4u*)(CL + t * VS + seg * 16) = c0; *(LAS v4u*)(CL + t * VS + seg * 16 + 8) = c1;
    }
    const float* nw_ = F.in[I_SNW] + g * 256 + hl * 64 + 32 * ph; const f32x4 nw0_ = *(const f32x4*)(nw_ + 4 * q), nw1_ = *(const f32x4*)(nw_ + 16 + 4 * q); const float Dh = F.in[I_DSSD][hd];
    if (PF) p4_ssd_load(F, nu >> 6, (nu & 63) >> 1, nu & 1, nx0, nx1, nx2, nx3, nb0, nb1, nc0, nc1, ntdt, ntb, nta);
    __syncthreads();
    {
        const int mi = F.wave >> 1;
#pragma unroll
        for (int jj = 0; jj < 2; ++jj) { const int nj = 2 * (F.wave & 1) + jj; if (nj <= mi) { f32x4 a = {0.f, 0.f, 0.f, 0.f};
#pragma unroll
            for (int kk = 0; kk < 4; ++kk) a = mfma16(lds_frag(CL + (16 * mi + l15) * VS + 32 * kk + 8 * q), lds_frag(BL + (16 * nj + l15) * VS + 32 * kk + 8 * q), a);
#pragma unroll
            for (int v = 0; v < 4; ++v) CB[(16 * mi + 4 * q + v) * TS + 16 * nj + l15] = a[v]; } }
    }
    __syncthreads();
    f32x4 ya[2][4], yb[2][4];
#pragma unroll
    for (int mp = 0; mp < 2; ++mp)
#pragma unroll
        for (int ni = 0; ni < 4; ++ni) { ya[mp][ni] = (f32x4){0.f, 0.f, 0.f, 0.f}; yb[mp][ni] = ya[mp][ni]; }
    const LAS float* ach = ACt + hl * 64; const LAS float* dth = DTt + hl * 64;
#pragma unroll
    for (int kk = 0; kk < 2; ++kk) { bf16x8 Aop[2]; const int j0 = 32 * kk + 8 * q;
#pragma unroll
        for (int mp = 0; mp < 2; ++mp) Aop[mp] = tr_frag(XN, XS, j0, j0 + 4, hl * 64 + 32 * ph + 16 * mp, F.lane);
        const f32x4 aj0 = *(const LAS f32x4*)(ach + j0), aj1 = *(const LAS f32x4*)(ach + j0 + 4), dj0 = *(const LAS f32x4*)(dth + j0), dj1 = *(const LAS f32x4*)(dth + j0 + 4);
#pragma unroll
        for (int ni = 0; ni < 4; ++ni) if (32 * kk <= 16 * ni + 15) { const int i = 16 * ni + l15; const float ai = ach[i];
            const f32x4 c0 = *(const LAS f32x4*)(CB + i * TS + j0), c1 = *(const LAS f32x4*)(CB + i * TS + j0 + 4);
            f32x4 m0, m1;
#pragma unroll
            for (int j = 0; j < 4; ++j) { m0[j] = (j0 + j <= i) ? c0[j] * fexp(ai - aj0[j]) * dj0[j] : 0.f; m1[j] = (j0 + 4 + j <= i) ? c1[j] * fexp(ai - aj1[j]) * dj1[j] : 0.f; }
            const bf16x8 Bop = pack8(m0, m1);
            ya[0][ni] = mfma16(Aop[0], Bop, ya[0][ni]); ya[1][ni] = mfma16(Aop[1], Bop, ya[1][ni]); } }
#pragma unroll
    for (int kk = 0; kk < 4; ++kk) { bf16x8 As[2];
#pragma unroll
        for (int mp = 0; mp < 2; ++mp) As[mp] = fp8x8_to_bf16(sin_[kk >> 1][mp][2 * (kk & 1)], sin_[kk >> 1][mp][2 * (kk & 1) + 1], 1.0f / SSSCALE);
#pragma unroll
        for (int ni = 0; ni < 4; ++ni) { const bf16x8 Bc = lds_frag(CL + (16 * ni + l15) * VS + 64 * (kk >> 1) + 16 * q + 8 * (kk & 1)); yb[0][ni] = mfma16(As[0], Bc, yb[0][ni]); yb[1][ni] = mfma16(As[1], Bc, yb[1][ni]); } }
    float ssq[4];
#pragma unroll
    for (int ni = 0; ni < 4; ++ni) { const int i = 16 * ni + l15; const float ea = fexp(ach[i]); ssq[ni] = 0.f;
#pragma unroll
        for (int mp = 0; mp < 2; ++mp) { const int p0 = 16 * mp + 4 * q; const v2u zv = zv_[ni][mp]; const v2u xv = *(const LAS v2u*)(XN + i * XS + hl * 64 + 32 * ph + p0);
            const float zf[4] = {bf2f(zv.x & 0xffffu), bf2f(zv.x >> 16), bf2f(zv.y & 0xffffu), bf2f(zv.y >> 16)}; const float xf[4] = {bf2f(xv.x & 0xffffu), bf2f(xv.x >> 16), bf2f(xv.y & 0xffffu), bf2f(xv.y >> 16)};
#pragma unroll
            for (int v = 0; v < 4; ++v) { float y = ya[mp][ni][v] + ea * yb[mp][ni][v] + Dh * xf[v]; y *= silu(zf[v]); ya[mp][ni][v] = y; ssq[ni] += y * y; } } }
#pragma unroll
    for (int ni = 0; ni < 4; ++ni) { float s = ssq[ni]; s += __shfl_xor(s, 16); s += __shfl_xor(s, 32); if (q == 0) SSQ[F.wave * 64 + 16 * ni + l15] = s; }
    __syncthreads();
    {
#pragma unroll
        for (int ni = 0; ni < 4; ++ni) { const int i = 16 * ni + l15; float tot = 0.f;
#pragma unroll
            for (int w = 0; w < 8; ++w) tot += SSQ[w * 64 + i];
            const float rs = 1.0f / sqrtf(tot * (1.0f / 256.0f) + 1e-5f);
            unsigned char* op = WSP(unsigned char, WS_MIXED) + (size_t)(tok0 + i) * D + 512 + g * 256 + hl * 64 + 32 * ph;
            *(v2u*)(op + 16 * (q & 1) + 4 * (q - (q & 1))) = widen8(pk_fp8s(ya[0][ni] * rs * nw0_, MSCALE), pk_fp8s(ya[1][ni] * rs * nw1_, MSCALE)); } }
    __syncthreads();
}

constexpr int LGS = 33;
DI void p6_route(const Frame& F) {
    LAS float* WR = (LAS float*)(F.lds);
    LAS float* LGP = (LAS float*)(F.lds + RING_BYTES);
    LAS float* SSP = LGP + 64 * LGS;
    LAS int* LCNT = (LAS int*)(SSP + 128);
    LAS int* LBASE = LCNT + 32;
    const float* rw = F.in[I_RW]; const float* nffn = F.in[I_NFFN]; const float* rbias = F.in[I_RB];
    {   f32x4 wv[16]; float sc[16];
#pragma unroll
        for (int i = 0; i < 16; ++i) { const int idx = F.tid + 512 * i; wv[i] = *(const f32x4*)(rw + (size_t)idx * 4); sc[i] = nffn[idx >> 3]; }
#pragma unroll
        for (int i = 0; i < 16; ++i) { const int idx = F.tid + 512 * i; *(LAS f32x4*)(WR + idx * 4) = wv[i] * sc[i]; } }
    __syncthreads();
    const int l15 = F.lane & 15, q = F.lane >> 4, rg = F.wave & 3, kh = F.wave >> 2;
    const bf16* X1 = WSP(bf16, WS_X1); unsigned* gcnt = WSP(unsigned, WS_CTL) + CW_CNT;
    for (int rb = F.bid; rb < T / 64; rb += F.G) {
        const int row0 = rb * 64;
        if (F.tid < 32) LCNT[F.tid] = 0;
        const bf16* xr = X1 + (size_t)(row0 + 16 * rg + l15) * D + 512 * kh + 4 * q;
        f32x4 a0 = {0.f, 0.f, 0.f, 0.f}, a1 = a0; float ss = 0.f; f32x4 xa[32];
#pragma unroll
        for (int j = 0; j < 32; ++j) { const v2u t_ = *(const v2u*)(xr + 16 * j); xa[j] = (f32x4){bf2f(t_.x & 0xffffu), bf2f(t_.x >> 16), bf2f(t_.y & 0xffffu), bf2f(t_.y >> 16)}; }
#pragma unroll
        for (int j = 0; j < 32; ++j) { const f32x4 a = xa[j]; ss += (a.x * a.x + a.y * a.y) + (a.z * a.z + a.w * a.w);
#pragma unroll
            for (int e = 0; e < 4; ++e) { const int k = 512 * kh + 16 * j + 4 * q + e; const float b0 = WR[k * 32 + l15], b1 = WR[k * 32 + 16 + l15];
                a0 = __builtin_amdgcn_mfma_f32_16x16x4f32(a[e], b0, a0, 0, 0, 0); a1 = __builtin_amdgcn_mfma_f32_16x16x4f32(a[e], b1, a1, 0, 0, 0); } }
        ss += __shfl_xor(ss, 16); ss += __shfl_xor(ss, 32);
        if (q == 0) SSP[kh * 64 + 16 * rg + l15] = ss;
        if (kh == 1) {
#pragma unroll
            for (int v = 0; v < 4; ++v) { LGP[(16 * rg + 4 * q + v) * LGS + l15] = a0[v]; LGP[(16 * rg + 4 * q + v) * LGS + 16 + l15] = a1[v]; } }
        __syncthreads();
        if (kh == 0) {
#pragma unroll
            for (int v = 0; v < 4; ++v) { LGP[(16 * rg + 4 * q + v) * LGS + l15] += a0[v]; LGP[(16 * rg + 4 * q + v) * LGS + 16 + l15] += a1[v]; } }
        __syncthreads();
        int ek[4] = {0, 0, 0, 0}, rk[4] = {0, 0, 0, 0}; float gk[4] = {0.f, 0.f, 0.f, 0.f};
        if (F.tid < 64) { const int row = F.tid; const float rs = 1.0f / sqrtf((SSP[row] + SSP[64 + row]) * (1.0f / D) + 1e-6f);
            WSP(float, WS_RSTD2)[row0 + row] = rs;
            float v0 = -3.0e38f, v1 = -3.0e38f, v2 = -3.0e38f, v3 = -3.0e38f; int i0 = 0, i1 = 0, i2 = 0, i3 = 0;
#pragma unroll 4
            for (int e = 0; e < NE; ++e) { const float v = LGP[row * LGS + e] * rs + rbias[e];
                if (v > v0) { v3 = v2; i3 = i2; v2 = v1; i2 = i1; v1 = v0; i1 = i0; v0 = v; i0 = e; }
                else if (v > v1) { v3 = v2; i3 = i2; v2 = v1; i2 = i1; v1 = v; i1 = e; }
                else if (v > v2) { v3 = v2; i3 = i2; v2 = v; i2 = e; }
                else if (v > v3) { v3 = v; i3 = e; } }
            const float e1 = fexp(v1 - v0), e2 = fexp(v2 - v0), e3 = fexp(v3 - v0), inv = 1.0f / (1.0f + e1 + e2 + e3);
            ek[0] = i0; ek[1] = i1; ek[2] = i2; ek[3] = i3; gk[0] = inv; gk[1] = e1 * inv; gk[2] = e2 * inv; gk[3] = e3 * inv;
#pragma unroll
            for (int k = 0; k < 4; ++k) rk[k] = __hip_atomic_fetch_add(LCNT + ek[k], 1, __ATOMIC_RELAXED, __HIP_MEMORY_SCOPE_WORKGROUP); }
        __syncthreads();
        if (F.tid < 32) { const int cN = LCNT[F.tid]; LBASE[F.tid] = cN ? (int)__hip_atomic_fetch_add(gcnt + F.tid, (unsigned)cN, RLX_AGENT) : 0; }
        __syncthreads();
        if (F.tid < 64) { int* list = WSP(int, WS_LIST); float* gw = WSP(float, WS_GATEW); const int tok = row0 + F.tid;
#pragma unroll
            for (int k = 0; k < 4; ++k) { list[(size_t)ek[k] * LISTCAP + LBASE[ek[k]] + rk[k]] = tok * 4 + k; gw[tok * 4 + k] = gk[k]; } }
        __syncthreads();
    }
}
DI void p6_route_slim(const Frame& F) {
    LAS float* LGP = (LAS float*)(F.lds);
    LAS float* SSP = LGP + 64 * LGS;
    LAS int* LCNT = (LAS int*)(SSP + 64);
    LAS int* LBASE = LCNT + 32;
    const float* rbias = F.in[I_RB]; const float* PART = WSP(float, WS_PART); const float* PSS = WSP(float, WS_PSS); unsigned* gcnt = WSP(unsigned, WS_CTL) + CW_CNT;
    float rbv[NE];
#pragma unroll
    for (int e = 0; e < NE; ++e) rbv[e] = rbias[e];
    for (int rb = F.bid; rb < T / 64; rb += F.G) {
        const int row0 = rb * 64;
        if (F.tid < 32) LCNT[F.tid] = 0;
        {   const int row = F.tid >> 3, j = F.tid & 7; const float* p = PART + (size_t)(row0 + row) * 32 + 4 * j; const float* ps = PSS + row0 + (F.tid & 63);
            const f32x4 p0 = *(const f32x4*)p, p1 = *(const f32x4*)(p + (size_t)T * 32), p2 = *(const f32x4*)(p + (size_t)2 * T * 32), p3 = *(const f32x4*)(p + (size_t)3 * T * 32);
            const float q0 = ps[0], q1 = ps[T], q2 = ps[2 * T], q3 = ps[3 * T];
            asm volatile("" :: "v"(p0), "v"(p1), "v"(p2), "v"(p3), "v"(q0), "v"(q1), "v"(q2), "v"(q3));
            const f32x4 s = add4(add4(p0, p1), add4(p2, p3));
            LGP[row * LGS + 4 * j] = s.x; LGP[row * LGS + 4 * j + 1] = s.y; LGP[row * LGS + 4 * j + 2] = s.z; LGP[row * LGS + 4 * j + 3] = s.w;
            if (F.tid < 64) SSP[F.tid] = (q0 + q1) + (q2 + q3); }
        __syncthreads();
        int ek[4] = {0, 0, 0, 0}, rk[4] = {0, 0, 0, 0}; float gk[4] = {0.f, 0.f, 0.f, 0.f};
        if (F.tid < 64) { const int row = F.tid; const float rs = 1.0f / sqrtf(SSP[row] * (1.0f / D) + 1e-6f);
            WSP(float, WS_RSTD2)[row0 + row] = rs;
            float v0 = -3.0e38f, v1 = -3.0e38f, v2 = -3.0e38f, v3 = -3.0e38f; int i0 = 0, i1 = 0, i2 = 0, i3 = 0;
#pragma unroll
            for (int e = 0; e < NE; ++e) { const float v = LGP[row * LGS + e] * rs + rbv[e];
                if (v > v0) { v3 = v2; i3 = i2; v2 = v1; i2 = i1; v1 = v0; i1 = i0; v0 = v; i0 = e; }
                else if (v > v1) { v3 = v2; i3 = i2; v2 = v1; i2 = i1; v1 = v; i1 = e; }
                else if (v > v2) { v3 = v2; i3 = i2; v2 = v; i2 = e; }
                else if (v > v3) { v3 = v; i3 = e; } }
            const float e1 = fexp(v1 - v0), e2 = fexp(v2 - v0), e3 = fexp(v3 - v0), inv = 1.0f / (1.0f + e1 + e2 + e3);
            ek[0] = i0; ek[1] = i1; ek[2] = i2; ek[3] = i3; gk[0] = inv; gk[1] = e1 * inv; gk[2] = e2 * inv; gk[3] = e3 * inv;
#pragma unroll
            for (int k = 0; k < 4; ++k) rk[k] = __hip_atomic_fetch_add(LCNT + ek[k], 1, __ATOMIC_RELAXED, __HIP_MEMORY_SCOPE_WORKGROUP); }
        __syncthreads();
        if (F.tid < 32) { const int cN = LCNT[F.tid]; LBASE[F.tid] = cN ? (int)__hip_atomic_fetch_add(gcnt + F.tid, (unsigned)cN, RLX_AGENT) : 0; }
        __syncthreads();
        if (F.tid < 64) { int* list = WSP(int, WS_LIST); float* gw = WSP(float, WS_GATEW); const int tok = row0 + F.tid;
#pragma unroll
            for (int k = 0; k < 4; ++k) { list[(size_t)ek[k] * LISTCAP + LBASE[ek[k]] + rk[k]] = tok * 4 + k; gw[tok * 4 + k] = gk[k]; } }
        __syncthreads();
    }
}
DI void moe_tables(const Frame& F) {
    LAS int* PT = (LAS int*)(F.lds + MOE_OFF); LAS int* CNT = PT + 40;
    if (F.tid < 64) {
        const int cn = F.tid < NE ? (int)__hip_atomic_load(WSP(unsigned, WS_CTL) + CW_CNT + F.tid, RLX_AGENT) : 0; const int nt_ = (cn + 255) >> 8; int inc = nt_;
#pragma unroll
        for (int o = 1; o < 32; o <<= 1) { const int up = __shfl_up(inc, o); if ((F.tid & 63) >= o) inc += up; }
        if (F.tid < NE) { CNT[F.tid] = cn; PT[F.tid] = inc - nt_; if (F.tid == NE - 1) PT[NE] = inc; } }
    __syncthreads();
}
DI void p9_final(const Frame& F) {
    const int gw = F.bid * 8 + F.wave, NGW = F.G * 8; const float* fw = F.in[I_FNW];
    f32x4 fwv[4];
#pragma unroll
    for (int j = 0; j < 4; ++j) fwv[j] = *((const f32x4*)fw + F.lane + 64 * j);
    for (int row = gw; row < T; row += 2 * NGW) {
        const int row2 = row + NGW < T ? row + NGW : row;
        v2u xa[2][4]; int ya[2][4][4];
#pragma unroll
        for (int r = 0; r < 2; ++r) { const int rw = r ? row2 : row; const v2u* xr = (const v2u*)(WSP(bf16, WS_X1) + (size_t)rw * D) + F.lane; const int* yr = (const int*)(WSP(unsigned char, WS_Y4) + (size_t)rw * 4 * D) + F.lane;
#pragma unroll
            for (int j = 0; j < 4; ++j) { xa[r][j] = xr[64 * j];
#pragma unroll
                for (int k = 0; k < 4; ++k) ya[r][j][k] = yr[k * 256 + 64 * j]; } }
        asm volatile("" : "+v"(xa[0][0]), "+v"(xa[0][1]), "+v"(xa[0][2]), "+v"(xa[0][3]) : "v"(xa[1][3]), "v"(ya[1][3][3]), "v"(ya[1][0][0]), "v"(xa[1][0]));
#pragma unroll
        for (int r = 0; r < 2; ++r) { const int rw = r ? row2 : row; if (r && row2 == row) break;
            f32x4 v[4]; float ss = 0.f;
#pragma unroll
            for (int j = 0; j < 4; ++j) { const v2u t_ = xa[r][j]; v[j] = (f32x4){bf2f(t_.x & 0xffffu), bf2f(t_.x >> 16), bf2f(t_.y & 0xffffu), bf2f(t_.y >> 16)}; f32x2 lo = {0.f, 0.f}, hi = {0.f, 0.f};
#pragma unroll
                for (int k = 0; k < 4; ++k) { const int y = ya[r][j][k]; lo += __builtin_amdgcn_cvt_pk_f32_fp8(y, false); hi += __builtin_amdgcn_cvt_pk_f32_fp8(y, true); }
                v[j].x += lo.x * YSCALE_INV; v[j].y += lo.y * YSCALE_INV; v[j].z += hi.x * YSCALE_INV; v[j].w += hi.y * YSCALE_INV;
                ss += (v[j].x * v[j].x + v[j].y * v[j].y) + (v[j].z * v[j].z + v[j].w * v[j].w); }
#pragma unroll
            for (int o = 1; o < 64; o <<= 1) ss += __shfl_xor(ss, o);
            const float rs = 1.0f / sqrtf(ss * (1.0f / D) + 1e-6f);
            f32x4* op = (f32x4*)(F.out + (size_t)rw * D) + F.lane;
#pragma unroll
            for (int j = 0; j < 4; ++j) op[64 * j] = v[j] * rs * fwv[j]; }
    }
}

__global__ void __launch_bounds__(512, 2) fwd(Args args) {
    extern __shared__ __attribute__((aligned(16))) unsigned char lds[];
    Frame F;
    F.lds = (LAS unsigned char*)lds; F.tid = threadIdx.x; F.lane = F.tid & 63; F.wave = __builtin_amdgcn_readfirstlane(F.tid >> 6); F.G = gridDim.x; F.bid = blockIdx.x;
    F.in = args.in; F.out = args.out; F.ws = args.ws;
    volatile LAS unsigned* MISC = (volatile LAS unsigned*)(F.lds + MISC_OFF);
    if (F.tid < 64) MISC[F.tid] = 0u;
    __syncthreads();
    XcdBarrier bar; bar.bar = WSP(unsigned, WS_CTL) + CW_BAR; bar.x = 0; bar.st = nullptr;
    if (N_LAUNCHES == 1) bar = xcd_barrier_post(WSP(unsigned, WS_CTL) + CW_BAR, MISC + 8);
    const int lo = args.ph_lo, hi = args.ph_hi;
#ifndef PH_MASK
#define PH_MASK 0x3ff
#endif
#define IN(k) ((((PH_MASK) >> (k)) & 1) && lo <= (k) && (k) < hi)
#ifndef BARREP
#define BARREP 0
#endif
#define SEAM(k) do { if (IN(k) && IN((k) + 1)) { xcd_barrier(bar); if (BARREP) xcd_barrier(bar); } } while (0)

#ifndef REPMASK
#define REPMASK 0
#endif
#define REP(k) (((REPMASK) >> (k)) & 1)
#define PH0() do { p0_prologue(F, !stag_); __syncthreads(); } while (0)
#define PH1() do { pg8::DenseOrder S; S.init(WSP(bf16, WS_XB), WSP(bf16, WS_WIN), T, NPROJ, D * 2, F.G, F.bid); \
        pg8::EpiProj E{WSP(bf16, WS_PROJ), WSP(float, WS_RSTD1)}; \
        pg8::gemm_phase<pg8::EpiProj, pg8::DenseOrder, true, false, false, false>(F.lds, D * 2, S, E); } while (0)
#ifndef UREP
#define UREP 0
#endif
#define PH2() do { int ul_[8]; int nu_ = 0; for (int u_ = F.bid; u_ < 1536 && nu_ < 8; u_ += F.G) { const int u = (F.bid & 1) ? F.bid + (1536 - F.G) - (u_ - F.bid) : u_; if (u >= 0 && u < 1536) ul_[nu_++] = u; } \
        if (F.G == 256 && nu_ == 6) { int us0, us1, ug0, ug1, ug2, ug3; if (F.bid & 1) { ug0 = ul_[0]; ug1 = ul_[1]; ug2 = ul_[2]; ug3 = ul_[3]; us0 = ul_[4]; us1 = ul_[5]; } else { us0 = ul_[0]; us1 = ul_[1]; ug0 = ul_[2]; ug1 = ul_[3]; ug2 = ul_[4]; ug3 = ul_[5]; } \
            if (F.bid & 1) { P2_GLA_RUN(); P2_SSD_RUN(); } else { P2_SSD_RUN(); P2_GLA_RUN(); } } \
        else { for (int i_ = 0; i_ < nu_; ++i_) { const int u = ul_[i_]; \
            if (u < 512) { P2S_DECL(a); p2_ssd_load(F, u >> 6, (u & 63) >> 1, u & 1, P2S_ARGS(a)); p2_ssd_unit<false>(F, u >> 6, (u & 63) >> 1, u & 1, P2S_ARGS(a), 0, P2S_ARGS(a)); } \
            else { const int v = u - 512; P2G_DECL(a); p2_gla_load(F, v >> 7, (v & 127) >> 2, v & 3, P2G_ARGS(a)); p2_gla_unit<false>(F, v >> 7, (v & 127) >> 2, v & 3, P2G_ARGS(a), 0, P2G_ARGS(a)); } } } } while (0)
#define P2_SSD_RUN() do { P2S_DECL(a); P2S_DECL(b); p2_ssd_load(F, us0 >> 6, (us0 & 63) >> 1, us0 & 1, P2S_ARGS(a)); \
        p2_ssd_unit<true>(F, us0 >> 6, (us0 & 63) >> 1, us0 & 1, P2S_ARGS(a), us1, P2S_ARGS(b)); \
        p2_ssd_unit<false>(F, us1 >> 6, (us1 & 63) >> 1, us1 & 1, P2S_ARGS(b), 0, P2S_ARGS(a)); } while (0)
#define P2_GU(u) ((u) - 512)
#define P2_GLA_RUN() do { P2G_DECL(a); P2G_DECL(b); p2_gla_load(F, P2_GU(ug0) >> 7, (P2_GU(ug0) & 127) >> 2, P2_GU(ug0) & 3, P2G_ARGS(a)); \
        p2_gla_unit<true>(F, P2_GU(ug0) >> 7, (P2_GU(ug0) & 127) >> 2, P2_GU(ug0) & 3, P2G_ARGS(a), ug1, P2G_ARGS(b)); \
        p2_gla_unit<true>(F, P2_GU(ug1) >> 7, (P2_GU(ug1) & 127) >> 2, P2_GU(ug1) & 3, P2G_ARGS(b), ug2, P2G_ARGS(a)); \
        p2_gla_unit<true>(F, P2_GU(ug2) >> 7, (P2_GU(ug2) & 127) >> 2, P2_GU(ug2) & 3, P2G_ARGS(a), ug3, P2G_ARGS(b)); \
        p2_gla_unit<false>(F, P2_GU(ug3) >> 7, (P2_GU(ug3) & 127) >> 2, P2_GU(ug3) & 3, P2G_ARGS(b), 0, P2G_ARGS(a)); } while (0)
#define PH4() do {   \
        int ul_[8]; int nu_ = 0; for (int u_ = F.bid; u_ < 1536 && nu_ < 8; u_ += F.G) { const int u = (F.bid & 1) ? F.bid + (1536 - F.G) - (u_ - F.bid) : u_; if (u >= 0 && u < 1536) ul_[nu_++] = u; } \
        if (F.G == 256 && nu_ == 6) { int us0, us1, ug0, ug1, ug2, ug3; if (F.bid & 1) { ug0 = ul_[0]; ug1 = ul_[1]; ug2 = ul_[2]; ug3 = ul_[3]; us0 = ul_[4]; us1 = ul_[5]; } else { us0 = ul_[0]; us1 = ul_[1]; ug0 = ul_[2]; ug1 = ul_[3]; ug2 = ul_[4]; ug3 = ul_[5]; } \
            v4u a0, a1, a2, a3, a4, a5, a6, a7, b0_, b1_, b2_, b3_, b4_, b5_, b6_, b7_; float at0, at1, at2, bt0, bt1, bt2; \
            if (F.bid & 1) { P4_GLA_RUN(); P4_SSD_RUN(); } else { P4_SSD_RUN(); P4_GLA_RUN(); } } \
        else { for (int i_ = 0; i_ < nu_; ++i_) { const int u = ul_[i_]; v4u a0, a1, a2, a3, a4, a5, a6, a7; float at0, at1, at2; \
            if (u < 512) { p4_ssd_load(F, u >> 6, (u & 63) >> 1, u & 1, a0, a1, a2, a3, a4, a5, a6, a7, at0, at1, at2); p4_ssd_unit<false>(F, u >> 6, (u & 63) >> 1, u & 1, a0, a1, a2, a3, a4, a5, a6, a7, at0, at1, at2, 0, a0, a1, a2, a3, a4, a5, a6, a7, at0, at1, at2); } \
            else { const int v = u - 512; p4_gla_load(F, v >> 7, (v & 127) >> 2, v & 3, a0, a1, a2, a3); p4_gla_unit<false>(F, v >> 7, (v & 127) >> 2, v & 3, a0, a1, a2, a3, 0, a0, a1, a2, a3); } } } } while (0)
#define P4_SSD_RUN() do { p4_ssd_load(F, us0 >> 6, (us0 & 63) >> 1, us0 & 1, a0, a1, a2, a3, a4, a5, a6, a7, at0, at1, at2); \
        p4_ssd_unit<true>(F, us0 >> 6, (us0 & 63) >> 1, us0 & 1, a0, a1, a2, a3, a4, a5, a6, a7, at0, at1, at2, us1, b0_, b1_, b2_, b3_, b4_, b5_, b6_, b7_, bt0, bt1, bt2); \
        p4_ssd_unit<false>(F, us1 >> 6, (us1 & 63) >> 1, us1 & 1, b0_, b1_, b2_, b3_, b4_, b5_, b6_, b7_, bt0, bt1, bt2, 0, a0, a1, a2, a3, a4, a5, a6, a7, at0, at1, at2); } while (0)
#define P4_GV(u) ((u) - 512)
#define P4_GLA_RUN() do { p4_gla_load(F, P4_GV(ug0) >> 7, (P4_GV(ug0) & 127) >> 2, P4_GV(ug0) & 3, a0, a1, a2, a3); \
        p4_gla_unit<true>(F, P4_GV(ug0) >> 7, (P4_GV(ug0) & 127) >> 2, P4_GV(ug0) & 3, a0, a1, a2, a3, ug1, b0_, b1_, b2_, b3_); \
        p4_gla_unit<true>(F, P4_GV(ug1) >> 7, (P4_GV(ug1) & 127) >> 2, P4_GV(ug1) & 3, b0_, b1_, b2_, b3_, ug2, a0, a1, a2, a3); \
        p4_gla_unit<true>(F, P4_GV(ug2) >> 7, (P4_GV(ug2) & 127) >> 2, P4_GV(ug2) & 3, a0, a1, a2, a3, ug3, b0_, b1_, b2_, b3_); \
        p4_gla_unit<false>(F, P4_GV(ug3) >> 7, (P4_GV(ug3) & 127) >> 2, P4_GV(ug3) & 3, b0_, b1_, b2_, b3_, 0, a0, a1, a2, a3); } while (0)
#define PH5() do { pg8::DenseOrder S; S.init(WSP(unsigned char, WS_MIXED), WSP(unsigned char, WS_WO), T, D, D, F.G, F.bid); S.lp = WSP(int, WS_LIST);     \
        if (F.G == 256) { pg8::EpiX1R E{F.in[I_X], WSP(bf16, WS_X1), WSP(unsigned char, WS_X1B), WSP(bf16, WS_WRT), WSP(float, WS_PART), WSP(float, WS_PSS), 1.0f / (WSCALE * MSCALE), WSP(bf16, WS_XB)};     \
            pg8::gemm_phase<pg8::EpiX1R, pg8::DenseOrder, true, true, true, true, true>(F.lds, D, S, E); } \
        else { pg8::EpiX1 E{F.in[I_X], WSP(bf16, WS_X1), WSP(unsigned char, WS_X1B), 1.0f / (WSCALE * MSCALE)}; \
            pg8::gemm_phase<pg8::EpiX1, pg8::DenseOrder, true, true, true, true, true>(F.lds, D, S, E); } } while (0)
#define PH7() do { moe_tables(F); \
        pg8::MoeOrder<8, true> S; S.A = (const char*)WSP(unsigned char, WS_X1B); S.Bt = (const char*)WSP(unsigned char, WS_WGU); S.list = WSP(int, WS_LIST); \
        S.PT = (const LAS int*)(F.lds + MOE_OFF); S.CNT = S.PT + 40; S.G = F.G; S.c = F.bid; S.tstep = (size_t)256 * D; S.estep = (size_t)2048 * D; S.astep = 0; \
        pg8::EpiAct E{WSP(unsigned char, WS_ACT), WSP(float, WS_RSTD2), F.in[I_BG], F.in[I_BU]}; \
        pg8::gemm_phase<pg8::EpiAct, pg8::MoeOrder<8, true>, true, true, true, true, false, KREP7>(F.lds, D, S, E); } while (0)
#define PH8() do {   \
        pg8::MoeOrder<4, false> S; S.A = (const char*)WSP(unsigned char, WS_ACT); S.Bt = (const char*)WSP(unsigned char, WS_WD); S.list = WSP(int, WS_LIST); \
        S.PT = (const LAS int*)(F.lds + MOE_OFF); S.CNT = S.PT + 40; S.G = F.G; S.c = F.bid; S.tstep = (size_t)256 * DFF; S.estep = (size_t)D * DFF; S.astep = (size_t)256 * DFF; \
        pg8::EpiDown E{WSP(unsigned char, WS_Y4), WSP(float, WS_GATEW), F.in[I_BD]}; \
        pg8::gemm_phase<pg8::EpiDown, pg8::MoeOrder<4, false>, true, true, true, true, true>(F.lds, DFF, S, E); } while (0)
    const bool stag_ = N_LAUNCHES == 1 && (F.G & 15) == 0 && IN(0) && IN(1) && !REP(0) && !REP(1);
    if (IN(0)) { PH0(); if (REP(0)) PH0(); }
    SEAM(0);
    if (IN(1)) {
        if (stag_) { if ((F.bid >> 3) & 1) { p0_experts(F); PH1(); } else { PH1(); __syncthreads(); p0_experts(F); } }
        else { PH1(); if (REP(1)) PH1(); } }
    SEAM(1);
    if (IN(2)) { PH2(); if (REP(2)) PH2(); }
    SEAM(2);
    if (IN(3)) { p3_scan(F); if (REP(3)) p3_scan(F); }
    SEAM(3);
    if (IN(4)) { PH4(); if (REP(4)) PH4(); }
    SEAM(4);
    if (IN(5)) { PH5(); if (REP(5)) PH5(); }
    SEAM(5);
    if (IN(6)) { if (F.G == 256) p6_route_slim(F); else p6_route(F); }
    SEAM(6);
    if (IN(7)) { PH7(); if (REP(7)) PH7(); }
    SEAM(7);
    if (IN(8)) { PH8(); if (REP(8)) PH8(); }
    SEAM(8);
    if (IN(9)) { p9_final(F); if (REP(9)) p9_final(F); }
#undef IN
#undef SEAM
}

extern "C" void kernel_launch(void* const* d_in, const int* in_sizes, int n_in, void* d_out, int out_size, void* d_ws, size_t ws_size, hipStream_t stream) {
    static int grid = 0;
    if (grid == 0) {
        if (n_in != 23 || in_sizes[0] != T * D || out_size != T * D || ws_size < WS_END) { fprintf(stderr, "kernel_launch: unexpected shapes (n_in %d, in0 %d, out %d, ws %zu); nothing launched\n", n_in, n_in > 0 ? in_sizes[0] : -1, out_size, ws_size); grid = -1; return; }
        int dev = 0, cus = 0, per_cu = 0;
        if (hipGetDevice(&dev) != hipSuccess || hipDeviceGetAttribute(&cus, hipDeviceAttributeMultiprocessorCount, dev) != hipSuccess) { grid = -1; return; }
        if (hipFuncSetAttribute((const void*)fwd, hipFuncAttributeMaxDynamicSharedMemorySize, LDS_BYTES) != hipSuccess) { fprintf(stderr, "kernel_launch: hipFuncSetAttribute failed\n"); grid = -1; return; }
        if (hipOccupancyMaxActiveBlocksPerMultiprocessor(&per_cu, (const void*)fwd, 512, LDS_BYTES) != hipSuccess || per_cu < 1) { fprintf(stderr, "kernel_launch: occupancy query says %d blocks per CU\n", per_cu); }
        (void)hipGetLastError();
        grid = cus;
    }
    if (grid < 0) return;
    (void)hipMemsetAsync((char*)d_ws + WS_CTL, 0, CTL_ZERO_BYTES, stream);
    Args a{};
    for (int i = 0; i < 23; ++i) a.in[i] = (const float*)d_in[i];
    a.out = (float*)d_out; a.ws = (unsigned char*)d_ws;
    if (N_LAUNCHES == 1) { a.ph_lo = 0; a.ph_hi = NPHASE; hipLaunchKernelGGL(fwd, dim3(grid), dim3(512), LDS_BYTES, stream, a); }
    else { for (int p = 0; p < NPHASE; ++p) { a.ph_lo = p; a.ph_hi = p + 1; hipLaunchKernelGGL(fwd, dim3(grid), dim3(512), LDS_BYTES, stream, a); } }
}
```
